# Optimizing an MI355X kernel written in HIP

```python
import math
import jax
import jax.numpy as jnp
from jax import lax
import numpy as np

D_MODEL = 1024
BATCH = 16
SEQ = 4096
DEPTH = 2

CHUNK = 64
EPS = 1e-6
NEG_INF = -1e30
Q_BLOCK = 128
N_MIXERS = 4
GROUP_W = D_MODEL // N_MIXERS
D_MIX = N_MIXERS * GROUP_W
HEAD_DIM = 64
POOL_WINDOWS = (2, 4, 8, 16)
N_POOL_GROUPS = len(POOL_WINDOWS)
POOL_GROUP = GROUP_W // N_POOL_GROUPS
CA_HEADS = GROUP_W // HEAD_DIM
CA_LEFT_CHUNKS = 8
CA_MAX_REL = 256
CA_REL_SIZE = CHUNK + CA_MAX_REL
SA_HEADS = GROUP_W // HEAD_DIM
IDX_HEADS = 8
IDX_DIM = 64
TOPK_MAX = 256
MLA_HEADS = 4
MLA_NOPE = 64
MLA_ROPE = 32
MLA_V = GROUP_W // MLA_HEADS
Q_LORA = 256
KV_LORA = 128
ROPE_BASE = 10000.0
T5_BUCKETS = 32
T5_MAX_DIST = 128
D_FF = -(-8 * D_MODEL // (3 * 256)) * 256

IN_SPLITS = (
    ('pool_u', GROUP_W),
    ('ca_q', GROUP_W), ('ca_k', GROUP_W), ('ca_v', GROUP_W),
    ('sa_q', GROUP_W), ('sa_k', HEAD_DIM), ('sa_v', HEAD_DIM),
    ('idx_q', IDX_HEADS * IDX_DIM), ('idx_k', IDX_DIM), ('idx_w', IDX_HEADS),
    ('mla_cq', Q_LORA), ('mla_ckv', KV_LORA), ('mla_kr', MLA_ROPE),
)
IN_NAMES = tuple(n for n, _ in IN_SPLITS)
IN_OFFSETS = tuple(int(o) for o in np.cumsum([w for _, w in IN_SPLITS])[:-1])
IN_WIDTH = sum(w for _, w in IN_SPLITS)

kernel_name = 'hybrid_parallel_head_group_streaming_encoder'


def rmsnorm(x, g):
    xf = x.astype(jnp.float32)
    y = xf * lax.rsqrt(jnp.mean(xf * xf, axis=-1, keepdims=True) + EPS)
    return (y * g.astype(jnp.float32)).astype(x.dtype)


def group_rmsnorm(y, g):
    B, S, W = y.shape
    yg = y.reshape(B, S, N_MIXERS, W // N_MIXERS).astype(jnp.float32)
    yg = yg * lax.rsqrt(jnp.mean(yg * yg, axis=-1, keepdims=True) + EPS)
    return (yg.reshape(B, S, W) * g.astype(jnp.float32)).astype(y.dtype)


def rope(x, pos):
    half = x.shape[-1] // 2
    freqs = ROPE_BASE ** (-jnp.arange(half, dtype=jnp.float32) / half)
    ang = pos.astype(jnp.float32)[:, None] * freqs[None, :]
    ang = ang.reshape((1, x.shape[1]) + (1,) * (x.ndim - 3) + (half,))
    cos, sin = jnp.cos(ang), jnp.sin(ang)
    x1 = x[..., :half].astype(jnp.float32)
    x2 = x[..., half:].astype(jnp.float32)
    return jnp.concatenate([x1 * cos - x2 * sin, x1 * sin + x2 * cos], axis=-1).astype(x.dtype)


def t5_bucket(rel):
    nb = T5_BUCKETS // 2
    max_exact = nb // 2
    ret = jnp.where(rel > 0, nb, 0)
    n = jnp.abs(rel)
    nf = jnp.maximum(n, 1).astype(jnp.float32)
    large = max_exact + (jnp.log(nf / max_exact) / math.log(T5_MAX_DIST / max_exact)
                         * (nb - max_exact)).astype(jnp.int32)
    large = jnp.minimum(large, nb - 1)
    return ret + jnp.where(n < max_exact, n, large)


def pool_mixer(u, w_grp, scale):
    B, S, _ = u.shape
    ug = u.reshape(B, S, N_POOL_GROUPS, POOL_GROUP).astype(jnp.float32)
    cs = jnp.cumsum(ug, axis=1, dtype=jnp.float32)
    t = jnp.arange(S)
    means = []
    for gi, w in enumerate(POOL_WINDOWS):
        c = cs[:, :, gi]
        lag = jnp.pad(c, ((0, 0), (w, 0), (0, 0)))[:, :S]
        cnt = jnp.minimum(t + 1, w).astype(jnp.float32)[None, :, None]
        means.append((c - lag) / cnt)
    d = (jnp.stack(means, axis=2) - ug).astype(u.dtype)
    y = jnp.einsum('bsgc,gcd->bsgd', d, w_grp).reshape(B, S, GROUP_W)
    return y * scale


def chunk_band_attention(q, k, v, rel_table):
    B, S, H, Dh = q.shape
    NC = S // CHUNK
    NB = CA_LEFT_CHUNKS + 1
    qc = q.reshape(B, NC, CHUNK, H, Dh)

    def band(a):
        ac = a.reshape(B, NC, CHUNK, H, Dh)
        ap = jnp.pad(ac, ((0, 0), (CA_LEFT_CHUNKS, 0), (0, 0), (0, 0), (0, 0)))
        return jnp.concatenate([ap[:, j:j + NC] for j in range(NB)], axis=2)

    kb, vb = band(k), band(v)
    s = jnp.einsum('bnqhd,bnkhd->bnhqk', qc, kb).astype(jnp.float32) * (Dh ** -0.5)
    qi = jnp.arange(CHUNK)
    kj = jnp.arange(NB * CHUNK)
    dist = (CA_LEFT_CHUNKS * CHUNK + qi[:, None]) - kj[None, :]
    ridx = jnp.clip(dist, -(CHUNK - 1), CA_MAX_REL) + (CHUNK - 1)
    bias = rel_table[:, ridx].astype(jnp.float32)
    key_chunk = jnp.arange(NC)[:, None] + (kj // CHUNK)[None, :] - CA_LEFT_CHUNKS
    valid = key_chunk >= 0
    s = jnp.where(valid[None, :, None, None, :], s + bias[None, None], NEG_INF)
    p = jax.nn.softmax(s, axis=-1).astype(v.dtype)
    o = jnp.einsum('bnhqk,bnkhd->bnqhd', p, vb)
    return o.reshape(B, S, H * Dh)


def dsa_attention(q, k, v, iq, ik, iw, t5_table):
    B, S, H, Dh = q.shape
    topk = min(TOPK_MAX, S // 4)
    n_blocks = S // Q_BLOCK
    kpos = jnp.arange(S, dtype=jnp.int32)
    iw = iw.astype(jnp.float32) * ((IDX_HEADS ** -0.5) * (IDX_DIM ** -0.5))
    gather = jax.vmap(lambda a, i: a[i])

    def block(bi):
        t0 = bi * Q_BLOCK
        qb = lax.dynamic_slice_in_dim(q, t0, Q_BLOCK, axis=1)
        iqb = lax.dynamic_slice_in_dim(iq, t0, Q_BLOCK, axis=1)
        iwb = lax.dynamic_slice_in_dim(iw, t0, Q_BLOCK, axis=1)
        qpos = t0 + jnp.arange(Q_BLOCK, dtype=jnp.int32)
        logits = jnp.einsum('bthd,bsd->bths', iqb, ik).astype(jnp.float32)
        score = jnp.einsum('bth,bths->bts', iwb, jax.nn.relu(logits))
        adm = (kpos[None, :] // CHUNK) <= (qpos[:, None] // CHUNK)
        score = jnp.where(adm[None], score, -jnp.inf)
        _, sel = lax.top_k(score, topk)
        kg = gather(k, sel)
        vg = gather(v, sel)
        s = jnp.einsum('bthd,btkd->bhtk', qb, kg).astype(jnp.float32) * (Dh ** -0.5)
        bias = t5_table[t5_bucket(sel - qpos[None, :, None])].astype(jnp.float32)
        s = s + jnp.moveaxis(bias, -1, 1)
        valid = (sel // CHUNK) <= (qpos[None, :, None] // CHUNK)
        s = jnp.where(valid[:, None], s, NEG_INF)
        p = jax.nn.softmax(s, axis=-1).astype(vg.dtype)
        return jnp.einsum('bhtk,btkd->bthd', p, vg)

    out = lax.map(block, jnp.arange(n_blocks))
    return jnp.moveaxis(out, 0, 1).reshape(B, S, H * Dh)


def mla_attention(cq, ckv, kr, g_cq, g_ckv, w_uq, w_ukv, pos):
    B, S, _ = cq.shape
    q = jnp.einsum('bsr,rhd->bshd', rmsnorm(cq, g_cq), w_uq)
    q_nope = q[..., :MLA_NOPE]
    q_rope = rope(q[..., MLA_NOPE:], pos)
    kv = jnp.einsum('bsr,rhd->bshd', rmsnorm(ckv, g_ckv), w_ukv)
    k_nope = kv[..., :MLA_NOPE]
    v = kv[..., MLA_NOPE:]
    k_rope = rope(kr, pos)
    scale = (MLA_NOPE + MLA_ROPE) ** -0.5
    kchunk = jnp.arange(S) // CHUNK

    def block(bi):
        t0 = bi * Q_BLOCK
        qn = lax.dynamic_slice_in_dim(q_nope, t0, Q_BLOCK, axis=1)
        qr = lax.dynamic_slice_in_dim(q_rope, t0, Q_BLOCK, axis=1)
        s = (jnp.einsum('bthd,bshd->bhts', qn, k_nope)
             + jnp.einsum('bthd,bsd->bhts', qr, k_rope)).astype(jnp.float32) * scale
        qchunk = (t0 + jnp.arange(Q_BLOCK)) // CHUNK
        mask = kchunk[None, :] <= qchunk[:, None]
        s = jnp.where(mask, s, NEG_INF)
        p = jax.nn.softmax(s, axis=-1).astype(v.dtype)
        return jnp.einsum('bhts,bshd->bthd', p, v)

    out = lax.map(block, jnp.arange(S // Q_BLOCK))
    return jnp.moveaxis(out, 0, 1).reshape(B, S, MLA_HEADS * MLA_V)


def setup_inputs(seed: int = 0) -> dict:
    key = jax.random.key(seed)
    ks = jax.random.split(key, 24)
    f32 = jnp.float32

    def nrm(k, shape, s):
        return jax.random.normal(k, shape, f32) * s

    def gain(k, shape):
        return 1.0 + 0.05 * jax.random.normal(k, shape, f32)

    L = DEPTH
    return {
        'x': nrm(ks[0], (BATCH, SEQ, D_MODEL), 1.0),
        'c': nrm(ks[1], (BATCH, D_MODEL), 1.0),
        't5_table': nrm(ks[2], (T5_BUCKETS, SA_HEADS), 0.5),
        'w_mod': nrm(ks[3], (L, D_MODEL, 6 * D_MODEL), 0.5 * D_MODEL ** -0.5),
        'b_mod': nrm(ks[4], (L, 6 * D_MODEL), 0.02),
        'g_mix': gain(ks[5], (L, D_MODEL)),
        'w_in': nrm(ks[6], (L, D_MODEL, IN_WIDTH), D_MODEL ** -0.5),
        'pool_w': nrm(ks[7], (L, N_POOL_GROUPS, POOL_GROUP, POOL_GROUP), POOL_GROUP ** -0.5),
        'pool_scale': 1.0 + 0.1 * jax.random.normal(ks[8], (L, GROUP_W), f32),
        'ca_rel': nrm(ks[9], (L, CA_HEADS, CA_REL_SIZE), 0.5),
        'mla_g_cq': gain(ks[10], (L, Q_LORA)),
        'mla_g_ckv': gain(ks[11], (L, KV_LORA)),
        'mla_w_uq': nrm(ks[12], (L, Q_LORA, MLA_HEADS, MLA_NOPE + MLA_ROPE), Q_LORA ** -0.5),
        'mla_w_ukv': nrm(ks[13], (L, KV_LORA, MLA_HEADS, MLA_NOPE + MLA_V), KV_LORA ** -0.5),
        'g_group': gain(ks[14], (L, D_MIX)),
        'w_out': nrm(ks[15], (L, D_MIX, D_MODEL), D_MIX ** -0.5),
        'g_ffn': gain(ks[16], (L, D_MODEL)),
        'ffn_w1': nrm(ks[17], (L, D_MODEL, D_FF), D_MODEL ** -0.5),
        'ffn_w3': nrm(ks[18], (L, D_MODEL, D_FF), D_MODEL ** -0.5),
        'ffn_w2': nrm(ks[19], (L, D_FF, D_MODEL), D_FF ** -0.5),
        'g_final': gain(ks[20], (D_MODEL,)),
    }


def reference(x, c, t5_table, w_mod, b_mod, g_mix, w_in, pool_w, pool_scale, ca_rel,
              mla_g_cq, mla_g_ckv, mla_w_uq, mla_w_ukv, g_group, w_out,
              g_ffn, ffn_w1, ffn_w3, ffn_w2, g_final):
    B, S, D = x.shape
    pos = jnp.arange(S, dtype=jnp.int32)
    c_act = jax.nn.silu(c)
    for l in range(DEPTH):
        mod = c_act @ w_mod[l] + b_mod[l]
        sh1, sc1, gt1, sh2, sc2, gt2 = jnp.split(mod[:, None, :], 6, axis=-1)
        h = rmsnorm(x, g_mix[l]) * (1.0 + sc1) + sh1
        z = h @ w_in[l]
        parts = dict(zip(IN_NAMES, jnp.split(z, IN_OFFSETS, axis=-1)))
        y_a = pool_mixer(parts['pool_u'], pool_w[l], pool_scale[l])
        y_b = chunk_band_attention(
            parts['ca_q'].reshape(B, S, CA_HEADS, HEAD_DIM),
            parts['ca_k'].reshape(B, S, CA_HEADS, HEAD_DIM),
            parts['ca_v'].reshape(B, S, CA_HEADS, HEAD_DIM),
            ca_rel[l])
        y_c = dsa_attention(
            parts['sa_q'].reshape(B, S, SA_HEADS, HEAD_DIM),
            parts['sa_k'], parts['sa_v'],
            parts['idx_q'].reshape(B, S, IDX_HEADS, IDX_DIM),
            parts['idx_k'], parts['idx_w'], t5_table)
        y_d = mla_attention(parts['mla_cq'], parts['mla_ckv'], parts['mla_kr'],
                            mla_g_cq[l], mla_g_ckv[l], mla_w_uq[l], mla_w_ukv[l], pos)
        mix = group_rmsnorm(jnp.concatenate([y_a, y_b, y_c, y_d], axis=-1), g_group[l])
        x = x + gt1 * (mix @ w_out[l])
        h = rmsnorm(x, g_ffn[l]) * (1.0 + sc2) + sh2
        f = (jax.nn.silu(h @ ffn_w1[l]) * (h @ ffn_w3[l])) @ ffn_w2[l]
        x = x + gt2 * f
    return rmsnorm(x, g_final)
```

```cpp
#include <hip/hip_runtime.h>
#include <cstdio>
#include <cstdint>

#ifndef MK_ONE_LAUNCH
#define MK_ONE_LAUNCH 1
#endif

#define GAS __attribute__((address_space(1)))
#define LAS __attribute__((address_space(3)))
typedef _Float16 h16;
typedef _Float16 h16x2 __attribute__((ext_vector_type(2)));
typedef _Float16 h16x4 __attribute__((ext_vector_type(4)));
typedef _Float16 h16x8 __attribute__((ext_vector_type(8)));
typedef float f32x4 __attribute__((ext_vector_type(4)));
typedef float f32x2 __attribute__((ext_vector_type(2)));
typedef unsigned u32x4 __attribute__((ext_vector_type(4)));
typedef unsigned long long u64;

constexpr int NB = 16, SEQ = 4096, DM = 1024, MROWS = NB * SEQ, NLAYER = 2;
constexpr int ZW = 2560, FF = 2816, FF2 = 2 * FF, INW = 2408;
constexpr int NTHR = 512, NWAVE = 8;
constexpr float EPSN = 1e-6f;
constexpr float LOG2E = 1.4426950408889634f;
constexpr int ZC_POOL = 0, ZC_CAQ = 256, ZC_CAK = 512, ZC_CAV = 768, ZC_SAQ = 1024, ZC_IDXQ = 1280, ZC_CQ = 1792, ZC_CKV = 2048, ZC_KR = 2176,
              ZC_SAK = 2208, ZC_SAV = 2304, ZC_IDXK = 2368, ZC_IDXW = 2432;
constexpr int MQW = 384, MKW = 384, MVW = 256;

constexpr size_t MiB = 1u << 20;
constexpr size_t WS_CTL = 0, CTL_ZERO_BYTES = 1 * MiB;
constexpr size_t WS_MOD = 1 * MiB;
constexpr size_t WS_ROPE = 2 * MiB;
constexpr size_t WS_W = 4 * MiB, W_LAYER = 24 * MiB;
constexpr size_t WO_IN = 0, WO_OUT = 5 * MiB, WO_UP = 7 * MiB, WO_DN = 18 * MiB;
constexpr size_t WS_TLW = 52 * MiB, TLW_LAYER = 512 * 1024;
constexpr size_t TO_UQ = 0, TO_UKV = 196608, TO_POOL = 327680;
constexpr size_t WS_SSQ = 3 * MiB;
constexpr size_t WS_SHW = 53 * MiB;
constexpr size_t WS_GMOD = 54 * MiB;
constexpr size_t WS_Z = 64 * MiB;
constexpr size_t WS_HY = 416 * MiB;
constexpr size_t WS_MQ = 544 * MiB, WS_MK = 592 * MiB, WS_MV = 640 * MiB;
constexpr size_t WS_BM = 672 * MiB;
constexpr size_t WS_IKB = 704 * MiB;
constexpr size_t WS_XG = 712 * MiB;
constexpr size_t WS_X16 = 840 * MiB;
constexpr size_t WS_END = 968 * MiB;
static_assert(WS_Z + (size_t)MROWS * FF * 2 <= WS_HY, "ws map");
static_assert(WO_DN + (size_t)DM * FF * 2 <= W_LAYER && WS_W + 2 * W_LAYER <= WS_Z, "ws map");

constexpr int CW_BAR = 4096;
constexpr int SCR_BYTES = 147456;
constexpr int MISC_OFF = SCR_BYTES;
constexpr int LDS_BYTES = SCR_BYTES + 256;

#define XB_TMO      128
#define XB_XCNT(j)  (256  + 64 * (j))
#define XB_XSUB(j)  (1280 + 64 * (j))
#define XB_XGEN(j)  (2304 + 64 * (j))
#define XB_TOP      3328
#define XB_TOPGEN   3392
#define XCD_BAR_WORDS 3456
#define XB_SPIN_CAP (1u << 23)
__device__ __forceinline__ unsigned xb_ld(unsigned* p)              { return __hip_atomic_load(p, __ATOMIC_RELAXED, __HIP_MEMORY_SCOPE_AGENT); }
__device__ __forceinline__ unsigned xb_add(unsigned* p, unsigned v) { return __hip_atomic_fetch_add(p, v, __ATOMIC_RELAXED, __HIP_MEMORY_SCOPE_AGENT); }
__device__ __forceinline__ unsigned xb_xcc_id() { return (unsigned)__builtin_amdgcn_s_getreg((3 << 11) | 20) & 0xFu; }
#define XB_SPIN(cond, bar) do { unsigned _sp = 0; while (cond) { __builtin_amdgcn_s_sleep(1); \
    if ((++_sp & 255u) == 0u) { if (xb_ld(&(bar)[XB_TMO])) break; if (_sp > XB_SPIN_CAP) { atomicAdd(&(bar)[XB_TMO], 1u); break; } } } } while (0)
struct XcdBarrier { unsigned* bar; unsigned x; volatile LAS unsigned* st; };
__device__ __forceinline__ XcdBarrier xcd_barrier_post(unsigned* bar, volatile LAS unsigned* st) {
    XcdBarrier b; b.bar = bar; b.x = xb_xcc_id(); b.st = st;
    if (threadIdx.x == 0) (void)xb_add(&bar[XB_XCNT(b.x)], 1u);
    return b;
}
__device__ __forceinline__ void xcd_barrier_complete(unsigned* bar, unsigned x, unsigned& nloc, unsigned& nx) {
    const unsigned G = gridDim.x * gridDim.y * gridDim.z;
    unsigned sum, cnt, mine, sp = 0u;
    for (;;) {
        sum = 0u; cnt = 0u; mine = 0u;
#pragma unroll
        for (unsigned j = 0; j < 16; ++j) { const unsigned c = xb_ld(&bar[XB_XCNT(j)]); sum += c; cnt += (c > 0u) ? 1u : 0u; mine = (j == x) ? c : mine; }
        if (sum == G) break;
        __builtin_amdgcn_s_sleep(1);
        if ((++sp & 255u) == 0u) { if (xb_ld(&bar[XB_TMO])) break; if (sp > XB_SPIN_CAP) { atomicAdd(&bar[XB_TMO], 1u); break; } }
    }
    nloc = mine > 0u ? mine : 1u; nx = cnt > 0u ? cnt : 1u;
}
__device__ __forceinline__ void xcd_barrier(const XcdBarrier& b) {
    asm volatile("s_waitcnt vmcnt(0)" ::: "memory");
    __syncthreads();
    if (threadIdx.x == 0) {
        unsigned* bar = b.bar;
        __builtin_amdgcn_s_waitcnt(0);
        unsigned nloc = b.st[0], nx = b.st[1];
        if (nloc == 0u) { xcd_barrier_complete(bar, b.x, nloc, nx); b.st[0] = nloc; b.st[1] = nx; }
        const unsigned old = xb_add(&bar[XB_XSUB(b.x)], 1u);
        const unsigned gen = old / nloc;
        if (old + 1u == (gen + 1u) * nloc) {
            __builtin_amdgcn_fence(__ATOMIC_RELEASE, "agent");
            asm volatile("s_waitcnt vmcnt(0)" ::: "memory");
            const unsigned og = xb_add(&bar[XB_TOP], 1u);
            const unsigned tg = og / nx;
            if (og + 1u == (tg + 1u) * nx) xb_add(&bar[XB_TOPGEN], 1u);
            else XB_SPIN(xb_ld(&bar[XB_TOPGEN]) == tg, bar);
            __builtin_amdgcn_fence(__ATOMIC_ACQUIRE, "agent");
            xb_add(&bar[XB_XGEN(b.x)], 1u);
            asm volatile("s_waitcnt vmcnt(0)" ::: "memory");
        } else {
            XB_SPIN(xb_ld(&bar[XB_XGEN(b.x)]) == gen, bar);
            __builtin_amdgcn_fence(__ATOMIC_ACQUIRE, "agent");
            asm volatile("s_waitcnt vmcnt(0)" ::: "memory");
        }
    }
    __syncthreads();
}

__device__ __forceinline__ float wave_sum(float v) {
#pragma unroll
    for (int o = 1; o < 64; o <<= 1) v += __shfl_xor(v, o);
    return v;
}
__device__ __forceinline__ float silu_f(float v) { return v * __builtin_amdgcn_rcpf(1.f + __builtin_amdgcn_exp2f(-1.4426950408889634f * v)); }
__device__ __forceinline__ int imin(int a, int b) { return a < b ? a : b; }
__device__ __forceinline__ int imax(int a, int b) { return a > b ? a : b; }

__device__ __forceinline__ int opaque_i(int v) { asm volatile("" : "+v"(v)); return v; }
__device__ __forceinline__ int opaque_s(int v) { asm volatile("" : "+s"(v)); return v; }
__device__ __forceinline__ unsigned char* opaque_p(unsigned char* p) { asm volatile("" : "+s"(p)); return p; }
#define PHASE_IDS const int tid = opaque_i((int)threadIdx.x), lane = tid & 63, wave = __builtin_amdgcn_readfirstlane(tid >> 6); const int G = opaque_s((int)gridDim.x), bx = opaque_s((int)blockIdx.x), gw = bx * NWAVE + wave, ngw = G * NWAVE; (void)tid; (void)lane; (void)wave; (void)gw; (void)ngw; (void)G; (void)bx;
#define PHASE_ENV(LL) PHASE_IDS const int l = opaque_s(LL); unsigned char* const ws = args.p.ws + (size_t)(unsigned)opaque_s(0); \
    float* const MOD = (float*)(ws + WS_MOD); float* const ROPE = (float*)(ws + WS_ROPE); h16* const Zb = (h16*)(ws + WS_Z); h16* const HID = (h16*)(ws + WS_Z); h16* const HY = (h16*)(ws + WS_HY); \
    h16* const MQ = (h16*)(ws + WS_MQ); h16* const MK = (h16*)(ws + WS_MK); h16* const MV = (h16*)(ws + WS_MV); u64* const BM = (u64*)(ws + WS_BM); \
    const float* const modl = MOD + (size_t)l * 16 * 6144; unsigned char* const wl = ws + WS_W + (size_t)l * W_LAYER; const float* const xin = (l == 0) ? P.x : (const float*)P.out; \
    (void)MOD; (void)ROPE; (void)Zb; (void)HID; (void)HY; (void)MQ; (void)MK; (void)MV; (void)BM; (void)modl; (void)wl; (void)xin;

struct Ptrs {
    const float* x; const float* c; const float* t5; const float* w_mod; const float* b_mod; const float* g_mix; const float* w_in;
    const float* pool_w; const float* pool_scale; const float* ca_rel; const float* g_cq; const float* g_ckv; const float* w_uq; const float* w_ukv;
    const float* g_group; const float* w_out; const float* g_ffn; const float* w1; const float* w3; const float* w2; const float* g_final;
    float* out; unsigned char* ws;
};
struct Args { Ptrs p; int ph_lo, ph_hi, use_bar, pad; };

__device__ __forceinline__ int zsrc_col(int n) {
    if (n < 1280) return n;
    if (n < 1792) return 1408 + (n - 1280);
    if (n < 2048) return 1992 + (n - 1792);
    if (n < 2176) return 2248 + (n - 2048);
    if (n < 2208) return 2376 + (n - 2176);
    if (n < 2272) return 1280 + (n - 2208);
    if (n < 2304) return -1;
    if (n < 2368) return 1344 + (n - 2304);
    if (n < 2432) return 1920 + (n - 2368);
    if (n < 2440) return 1984 + (n - 2432);
    return -1;
}

template <class Src>
__device__ __forceinline__ void cvt_item(h16* WT, int K, int n0, int k0, LAS float* scr, int lane, const Src& src) {
#pragma unroll 4
    for (int i = 0; i < 32; ++i) { const int kk = 2 * i + (lane >> 5); scr[kk * 33 + (lane & 31)] = src(n0 + (lane & 31), k0 + kk); }
    asm volatile("s_waitcnt lgkmcnt(0)" ::: "memory");
    const int c = lane & 7;
#pragma unroll
    for (int j = 0; j < 4; ++j) {
        const int n = (lane >> 3) + 8 * j; const LAS float* s = scr + (8 * c) * 33 + n;
        h16x8 o;
#pragma unroll
        for (int e = 0; e < 8; ++e) o[e] = (h16)s[e * 33];
        *(h16x8*)(WT + (size_t)(n0 + n) * K + k0 + 8 * c) = o;
    }
    asm volatile("s_waitcnt lgkmcnt(0)" ::: "memory");
}

template <class Epi>
__device__ __forceinline__ void naive_gemm(LAS unsigned char* lds, const h16* A, const h16* Bt, int Mr, int N, int K, const Epi& E) {
    const int tid = opaque_i((int)threadIdx.x), ty = tid >> 4, tx = tid & 15;
    LAS float* As = (LAS float*)lds;
    LAS float* Bs = As + 32 * 132;
    const int nM = Mr / 128, nN = N / 128, ntile = nM * nN;
    const int lr = tid >> 2, lc = (tid & 3) * 8;
    for (int tile = blockIdx.x; tile < ntile; tile += gridDim.x) {
        const int pm = tile / nN, pn = tile % nN;
        float acc[4][8];
#pragma unroll
        for (int i = 0; i < 4; ++i)
#pragma unroll
            for (int j = 0; j < 8; ++j) acc[i][j] = 0.f;
        const h16* Ap = A + (size_t)(pm * 128 + lr) * K + lc;
        const h16* Bp = Bt + (size_t)(pn * 128 + lr) * K + lc;
        for (int k0 = 0; k0 < K; k0 += 32) {
            const h16x8 av = *(const h16x8*)(Ap + k0), bv = *(const h16x8*)(Bp + k0);
            __syncthreads();
#pragma unroll
            for (int e = 0; e < 8; ++e) { As[(lc + e) * 132 + lr] = (float)av[e]; Bs[(lc + e) * 132 + lr] = (float)bv[e]; }
            __syncthreads();
#pragma unroll 8
            for (int k = 0; k < 32; ++k) {
                const f32x4 a = *(const LAS f32x4*)(As + k * 132 + ty * 4);
                const f32x4 b0 = *(const LAS f32x4*)(Bs + k * 132 + tx * 8), b1 = *(const LAS f32x4*)(Bs + k * 132 + tx * 8 + 4);
#pragma unroll
                for (int i = 0; i < 4; ++i) {
                    acc[i][0] += a[i] * b0[0]; acc[i][1] += a[i] * b0[1]; acc[i][2] += a[i] * b0[2]; acc[i][3] += a[i] * b0[3];
                    acc[i][4] += a[i] * b1[0]; acc[i][5] += a[i] * b1[1]; acc[i][6] += a[i] * b1[2]; acc[i][7] += a[i] * b1[3];
                }
            }
        }
#pragma unroll
        for (int i = 0; i < 4; ++i) E.emit8(pm * 128 + ty * 4 + i, pn * 128 + tx * 8, acc[i]);
    }
    __syncthreads();
}
struct EpiZ {
    h16* O; int ldo; h16* IK;
    __device__ __forceinline__ void emit8(int row, int col, const float (&v)[8]) const {
        h16x8 o;
#pragma unroll
        for (int e = 0; e < 8; ++e) o[e] = (h16)v[e];
        *(h16x8*)(O + (size_t)row * ldo + col) = o;
        if (col >= ZC_IDXK && col < ZC_IDXK + 64) *(h16x8*)(IK + (size_t)row * 64 + (col - ZC_IDXK)) = o;
    }
};
struct EpiRes {
    const float* xin; float* xout; const float* gate;
    __device__ __forceinline__ void emit8(int row, int col, const float (&v)[8]) const {
        const int b = row >> 12;
        const float* g = gate + (size_t)b * 6144 + col; const float* xi = xin + (size_t)row * DM + col; float* xo = xout + (size_t)row * DM + col;
        const f32x4 g0 = *(const f32x4*)g, g1 = *(const f32x4*)(g + 4), x0 = *(const f32x4*)xi, x1 = *(const f32x4*)(xi + 4);
        f32x4 o0, o1;
#pragma unroll
        for (int e = 0; e < 4; ++e) { o0[e] = x0[e] + g0[e] * v[e]; o1[e] = x1[e] + g1[e] * v[4 + e]; }
        *(f32x4*)xo = o0; *(f32x4*)(xo + 4) = o1;
    }
};
struct EpiSwi {
    h16* O;
    __device__ __forceinline__ void emit8(int row, int col, const float (&v)[8]) const {
        h16x4 o;
#pragma unroll
        for (int j = 0; j < 4; ++j) o[j] = (h16)(silu_f(v[2 * j]) * v[2 * j + 1]);
        *(h16x4*)(O + (size_t)row * FF + (col >> 1)) = o;
    }
};


namespace pg8 {
#define PG8_LAS __attribute__((address_space(3)))
typedef _Float16 bf16_t;
constexpr int BM = 256, BK = 64, HALF = 128, HTB = HALF * BK * 2, STAGE_BYTES = 8 * HTB, NXCD = 8, WGM = 8;
__host__ __device__ __forceinline__ int lds_byte(int r, int c) { const int st = (r >> 4) * 2 + (c >> 5), rr = r & 15, cc = c & 31, ob = rr * 64 + cc * 2; return st * 1024 + (ob ^ (((ob >> 9) & 1) << 5)); }
__host__ __device__ __forceinline__ void stage_rc(int b, int& R, int& C) { const int st = b / 1024, sb = b % 1024, swz = sb ^ (((sb >> 9) & 1) << 5); R = (st >> 1) * 16 + swz / 64; C = (st & 1) * 32 + (swz % 64) / 2; }
__host__ __device__ __forceinline__ int perm32(int rho) { const int n = rho >> 4, i = rho & 15; return 8 * (i >> 2) + 4 * n + (i & 3); }
struct Unit { int pm, pn; };
struct Gemm { const bf16_t* A; const bf16_t* Bt; int M, N, K; };
struct StaticOrder {
    int nM, nN, nwg, G, c;
    __host__ __device__ void init(int M, int N, int G_, int c_) { nM = M / BM; nN = N / BM; nwg = nM * nN; G = G_; c = c_; }
    __host__ __device__ bool next(int i, Unit& u) const {
        const long L = (long)i * G + c; if (L >= nwg) return false;
        int wgid = (int)L; { const int q = nwg / NXCD, r = nwg % NXCD, xcd = wgid % NXCD, off = wgid / NXCD; wgid = (xcd < r ? xcd * (q + 1) : r * (q + 1) + (xcd - r) * q) + off; }
        const int nig = WGM * nN, gid = wgid / nig, fm = gid * WGM, gsz = (nM - fm) < WGM ? (nM - fm) : WGM;
        u.pm = fm + ((wgid % nig) % gsz); u.pn = (wgid % nig) / gsz; return true;
    }
    __device__ __forceinline__ void a_ready(const Unit&) const {}
    __device__ __forceinline__ void done(const Unit&) const {}
};
template <class E8> struct EpiWrap {
    static constexpr bool PERM = true, AFTER_DRAIN = false, IDEMPOTENT = false;
    E8 e;
    __device__ __forceinline__ void operator()(const f32x4 (&acc)[2][2][4][2], const Unit& u, int wr, int wc, int fr, int fq) const {
#pragma unroll
        for (int ai = 0; ai < 2; ++ai)
#pragma unroll
            for (int m = 0; m < 4; ++m)
#pragma unroll
                for (int bj = 0; bj < 2; ++bj) {
                    const float v[8] = {acc[ai][bj][m][0][0], acc[ai][bj][m][0][1], acc[ai][bj][m][0][2], acc[ai][bj][m][0][3], acc[ai][bj][m][1][0], acc[ai][bj][m][1][1], acc[ai][bj][m][1][2], acc[ai][bj][m][1][3]};
                    e.emit8(u.pm * BM + ai * HALF + wr * 64 + m * 16 + fr, u.pn * BM + bj * HALF + wc * 32 + 8 * fq, v);
                }
    }
};
template <class Epi, class Sched, bool ALIGN_EPI = false, bool SP2 = false>
__device__ __forceinline__ void gemm_phase(PG8_LAS unsigned char* lds, const Gemm g, const Sched& S, const Epi& E) {
    const int tid = opaque_i((int)threadIdx.x), wid = __builtin_amdgcn_readfirstlane(tid >> 6), lane = tid & 63, wr = wid >> 2, wc = wid & 3, fr = lane & 15, fq = lane >> 4;
    const int K = g.K, nt = K / BK;
    unsigned voffA[2], voffB[2];
#pragma unroll
    for (int i = 0; i < 2; ++i) { int R, C; stage_rc(tid * 16 + i * 8192, R, C); const int Rb = Epi::PERM ? ((R & ~31) + perm32(R & 31)) : R;
        voffA[i] = (unsigned)(R * K + C) * 2u; voffB[i] = (unsigned)(Rb * K + C) * 2u; }
    const size_t kstep = (size_t)(BK * 2);
    const size_t hstep = (size_t)HALF * K * 2;
    const size_t tstep = 2 * hstep;
    const unsigned ldsw = (unsigned)wid * 1024u;
    const int aoff = lds_byte(wr * 64 + fr, fq * 8), boff = lds_byte(wc * 32 + fr, fq * 8);
#define PG8_SA(b, h) (((b) * 2 + (h)) * HTB)
#define PG8_SB(b, h) ((4 + (b) * 2 + (h)) * HTB)
#define PG8_STAGE(bufoff, gbase, voff) do { _Pragma("unroll") for (int _i = 0; _i < 2; ++_i) \
        __builtin_amdgcn_global_load_lds((const unsigned*)((const char*)(gbase) + (voff)[_i]), (PG8_LAS unsigned*)(lds + (bufoff) + ldsw + _i * 8192), 16, 0, 0); } while (0)
#define PG8_LDA(dst, b, h) do { _Pragma("unroll") for (int m = 0; m < 4; ++m) _Pragma("unroll") for (int k = 0; k < 2; ++k) dst[m][k] = *(const PG8_LAS h16x8*)(lds + PG8_SA(b, h) + aoff + m * 2048 + k * 1024); } while (0)
#define PG8_LDB(dst, b, h) do { _Pragma("unroll") for (int n = 0; n < 2; ++n) _Pragma("unroll") for (int k = 0; k < 2; ++k) dst[n][k] = *(const PG8_LAS h16x8*)(lds + PG8_SB(b, h) + boff + n * 2048 + k * 1024); } while (0)
#define PG8_MMA(ai, bj, At, Bt) do { __builtin_amdgcn_s_setprio(1); _Pragma("unroll") for (int m = 0; m < 4; ++m) _Pragma("unroll") for (int n = 0; n < 2; ++n) _Pragma("unroll") for (int k = 0; k < 2; ++k) \
        acc[ai][bj][m][n] = __builtin_amdgcn_mfma_f32_16x16x32_f16(Bt[n][k], At[m][k], acc[ai][bj][m][n], 0, 0, 0); __builtin_amdgcn_s_setprio(0); } while (0)
#define PG8_WAIT_V(n) asm volatile("s_waitcnt vmcnt(" #n ")" ::: "memory")
#define PG8_WAIT_L(n) asm volatile("s_waitcnt lgkmcnt(" #n ")" ::: "memory")
#define PG8_BAR __builtin_amdgcn_s_barrier()
#define PG8_SCHED __builtin_amdgcn_sched_barrier(0)
    Unit cur, nxt; int ui = 0;
    if (!S.next(0, cur)) return;
    f32x4 acc[2][2][4][2];
#pragma unroll
    for (int a = 0; a < 2; ++a)
#pragma unroll
        for (int b = 0; b < 2; ++b)
#pragma unroll
            for (int m = 0; m < 4; ++m)
#pragma unroll
                for (int n = 0; n < 2; ++n) acc[a][b][m][n] = (f32x4){0.f, 0.f, 0.f, 0.f};
    h16x8 At[4][2], B0[2][2], B1[2][2];
    const char* cA = (const char*)g.A + (size_t)cur.pm * tstep; const char* cB = (const char*)g.Bt + (size_t)cur.pn * tstep;
    S.a_ready(cur);
    if constexpr (SP2) {
        PG8_STAGE(PG8_SB(0, 0), cB, voffB); PG8_STAGE(PG8_SB(0, 1), cB + hstep, voffB); PG8_STAGE(PG8_SA(0, 0), cA, voffA); PG8_STAGE(PG8_SA(0, 1), cA + hstep, voffA);
        if (wr == 1) PG8_BAR;
        PG8_WAIT_V(2); PG8_BAR;
        PG8_STAGE(PG8_SB(1, 0), cB + kstep, voffB); PG8_STAGE(PG8_SA(1, 0), cA + kstep, voffA); PG8_STAGE(PG8_SB(1, 1), cB + hstep + kstep, voffB);
        PG8_WAIT_V(6); PG8_BAR;
    } else {
        PG8_STAGE(PG8_SB(0, 0), cB, voffB); PG8_STAGE(PG8_SA(0, 0), cA, voffA); PG8_STAGE(PG8_SB(0, 1), cB + hstep, voffB); PG8_STAGE(PG8_SA(0, 1), cA + hstep, voffA);
        if (wr == 1) PG8_BAR;
        PG8_WAIT_V(4); PG8_BAR;
        PG8_STAGE(PG8_SB(1, 0), cB + kstep, voffB); PG8_STAGE(PG8_SA(1, 0), cA + kstep, voffA); PG8_STAGE(PG8_SB(1, 1), cB + hstep + kstep, voffB);
        PG8_WAIT_V(6); PG8_BAR;
    }
    for (;;) {
        const bool has_next = S.next(ui + 1, nxt);
        const char* nA = has_next ? (const char*)g.A + (size_t)nxt.pm * tstep : cA; const char* nB = has_next ? (const char*)g.Bt + (size_t)nxt.pn * tstep : cB;
        for (int t = 0; t < nt; t += 2) {
            const bool last = (t == nt - 2);
            const char* a1 = cA + (size_t)(t + 1) * kstep;
            const char* a2 = last ? nA : cA + (size_t)(t + 2) * kstep; const char* b2 = last ? nB : cB + (size_t)(t + 2) * kstep;
            const char* a3 = a2 + kstep; const char* b3 = b2 + kstep;
            if (last && has_next) S.a_ready(nxt);
            if constexpr (SP2) {
            PG8_LDB(B0, 0, 0); PG8_LDB(B1, 0, 1); PG8_SCHED; PG8_LDA(At, 0, 0); PG8_STAGE(PG8_SA(1, 1), a1 + hstep, voffA);
            PG8_WAIT_V(8); PG8_WAIT_L(0); PG8_BAR; PG8_MMA(0, 0, At, B0); PG8_MMA(0, 1, At, B1); PG8_BAR; PG8_SCHED;
            PG8_LDA(At, 0, 1); PG8_STAGE(PG8_SB(0, 0), b2, voffB); PG8_STAGE(PG8_SB(0, 1), b2 + hstep, voffB); PG8_STAGE(PG8_SA(0, 0), a2, voffA);
            PG8_WAIT_V(8); PG8_WAIT_L(0); PG8_BAR; PG8_MMA(1, 0, At, B0); PG8_MMA(1, 1, At, B1); PG8_BAR; PG8_SCHED;
            PG8_LDB(B0, 1, 0); PG8_LDB(B1, 1, 1); PG8_SCHED; PG8_LDA(At, 1, 0); PG8_STAGE(PG8_SA(0, 1), a2 + hstep, voffA);
            PG8_WAIT_V(8); PG8_WAIT_L(0); PG8_BAR; PG8_MMA(0, 0, At, B0); PG8_MMA(0, 1, At, B1); PG8_BAR; PG8_SCHED;
            PG8_LDA(At, 1, 1); PG8_STAGE(PG8_SB(1, 0), b3, voffB); PG8_STAGE(PG8_SB(1, 1), b3 + hstep, voffB); PG8_STAGE(PG8_SA(1, 0), a3, voffA);
            PG8_WAIT_V(8); PG8_WAIT_L(0); PG8_BAR; PG8_MMA(1, 0, At, B0); PG8_MMA(1, 1, At, B1); PG8_BAR; PG8_SCHED;
            } else {
            PG8_LDB(B0, 0, 0); PG8_SCHED; PG8_LDA(At, 0, 0); PG8_STAGE(PG8_SA(1, 1), a1 + hstep, voffA);
            PG8_WAIT_L(8); PG8_BAR; PG8_WAIT_L(0); PG8_MMA(0, 0, At, B0); PG8_BAR; PG8_SCHED;
            PG8_LDB(B1, 0, 1); PG8_STAGE(PG8_SB(0, 0), b2, voffB);
            PG8_BAR; PG8_WAIT_L(0); PG8_MMA(0, 1, At, B1); PG8_BAR;
            PG8_LDA(At, 0, 1); PG8_STAGE(PG8_SA(0, 0), a2, voffA);
            PG8_BAR; PG8_WAIT_L(0); PG8_MMA(1, 0, At, B0); PG8_BAR; PG8_SCHED;
            PG8_STAGE(PG8_SB(0, 1), b2 + hstep, voffB);
            PG8_WAIT_V(6); PG8_BAR; PG8_MMA(1, 1, At, B1); PG8_BAR;
            PG8_LDB(B0, 1, 0); PG8_SCHED; PG8_LDA(At, 1, 0); PG8_STAGE(PG8_SA(0, 1), a2 + hstep, voffA);
            PG8_WAIT_L(8); PG8_BAR; PG8_WAIT_L(0); PG8_MMA(0, 0, At, B0); PG8_BAR; PG8_SCHED;
            PG8_LDB(B1, 1, 1); PG8_STAGE(PG8_SB(1, 0), b3, voffB);
            PG8_BAR; PG8_WAIT_L(0); PG8_MMA(0, 1, At, B1); PG8_BAR;
            PG8_LDA(At, 1, 1); PG8_STAGE(PG8_SA(1, 0), a3, voffA);
            PG8_BAR; PG8_WAIT_L(0); PG8_MMA(1, 0, At, B0); PG8_BAR; PG8_SCHED;
            PG8_STAGE(PG8_SB(1, 1), b3 + hstep, voffB);
            PG8_WAIT_V(6); PG8_BAR; PG8_MMA(1, 1, At, B1); PG8_BAR;
            }
        }
        if constexpr (ALIGN_EPI) { if (wr == 0) PG8_BAR; }
        if constexpr (!Epi::AFTER_DRAIN) { E(acc, cur, wr, wc, fr, fq);
#if PROBE_PHASE == 17
            if constexpr (Epi::IDEMPOTENT) { asm volatile("" ::: "memory"); E(acc, cur, wr, wc, fr, fq); }
#endif
            S.done(cur); }
        if (!has_next) break;
#pragma unroll
        for (int a = 0; a < 2; ++a)
#pragma unroll
            for (int b = 0; b < 2; ++b)
#pragma unroll
                for (int m = 0; m < 4; ++m)
#pragma unroll
                    for (int n = 0; n < 2; ++n) acc[a][b][m][n] = (f32x4){0.f, 0.f, 0.f, 0.f};
        cur = nxt; cA = nA; cB = nB; ++ui;
        if constexpr (ALIGN_EPI) { if (wr == 1) PG8_BAR; }
    }
    PG8_WAIT_V(0);
    if constexpr (!ALIGN_EPI) { if (wr == 0) PG8_BAR; }
    PG8_BAR;
    if constexpr (Epi::AFTER_DRAIN) { E.fused(acc, cur, wr, wc, fr, fq, lds, wid, lane); S.done(cur); }
#undef PG8_SA
#undef PG8_SB
#undef PG8_STAGE
#undef PG8_LDA
#undef PG8_LDB
#undef PG8_MMA
#undef PG8_WAIT_V
#undef PG8_WAIT_L
#undef PG8_BAR
#undef PG8_SCHED
}
}

struct EpiZn {
    static constexpr bool PERM = true, AFTER_DRAIN = false, IDEMPOTENT = true;
    h16* O; int ldo; h16* IK; const float* ssq; const float* shw;
    __device__ __forceinline__ void operator()(const f32x4 (&acc)[2][2][4][2], const pg8::Unit& u, int wr, int wc, int fr, int fq) const {
        const int row00 = u.pm * pg8::BM + wr * 64 + fr, b = row00 >> 12, col0 = u.pn * pg8::BM + wc * 32 + 8 * fq;
        f32x4 sh[2][2]; float rs[2][4];
#pragma unroll
        for (int bj = 0; bj < 2; ++bj) { const float* sp = shw + (size_t)b * 8192 + col0 + bj * pg8::HALF; sh[bj][0] = *(const f32x4*)sp; sh[bj][1] = *(const f32x4*)(sp + 4); }
#pragma unroll
        for (int ai = 0; ai < 2; ++ai)
#pragma unroll
            for (int m = 0; m < 4; ++m) rs[ai][m] = ssq[row00 + ai * pg8::HALF + m * 16];
#pragma unroll
        for (int ai = 0; ai < 2; ++ai)
#pragma unroll
            for (int m = 0; m < 4; ++m) {
                const int row = row00 + ai * pg8::HALF + m * 16;
                const float r = rsqrtf(rs[ai][m] * (1.f / DM) + EPSN);
#pragma unroll
                for (int bj = 0; bj < 2; ++bj) {
                    const int col = col0 + bj * pg8::HALF;
                    h16x8 o;
#pragma unroll
                    for (int e = 0; e < 4; ++e) { o[e] = (h16)(r * acc[ai][bj][m][0][e] + sh[bj][0][e]); o[4 + e] = (h16)(r * acc[ai][bj][m][1][e] + sh[bj][1][e]); }
                    *(h16x8*)(O + (size_t)row * ldo + col) = o;
                    if (col >= ZC_IDXK && col < ZC_IDXK + 64) *(h16x8*)(IK + (size_t)row * 64 + (col - ZC_IDXK)) = o;
                }
            }
    }
};
struct EpiSwin {
    static constexpr bool PERM = true, AFTER_DRAIN = false, IDEMPOTENT = true;
    h16* O; const float* ssq; const float* shw;
    __device__ __forceinline__ void operator()(const f32x4 (&acc)[2][2][4][2], const pg8::Unit& u, int wr, int wc, int fr, int fq) const {
        const int row00 = u.pm * pg8::BM + wr * 64 + fr, b = row00 >> 12, col0 = u.pn * pg8::BM + wc * 32 + 8 * fq;
        f32x4 sh[2][2]; float rs[2][4];
#pragma unroll
        for (int bj = 0; bj < 2; ++bj) { const float* sp = shw + (size_t)b * 8192 + col0 + bj * pg8::HALF; sh[bj][0] = *(const f32x4*)sp; sh[bj][1] = *(const f32x4*)(sp + 4); }
#pragma unroll
        for (int ai = 0; ai < 2; ++ai)
#pragma unroll
            for (int m = 0; m < 4; ++m) rs[ai][m] = ssq[row00 + ai * pg8::HALF + m * 16];
#pragma unroll
        for (int ai = 0; ai < 2; ++ai)
#pragma unroll
            for (int m = 0; m < 4; ++m) {
                const int row = row00 + ai * pg8::HALF + m * 16;
                const float r = rsqrtf(rs[ai][m] * (1.f / DM) + EPSN);
#pragma unroll
                for (int bj = 0; bj < 2; ++bj) {
                    const f32x4 v0 = acc[ai][bj][m][0], v1 = acc[ai][bj][m][1];
                    const float a0 = r * v0[0] + sh[bj][0][0], b0 = r * v0[1] + sh[bj][0][1], a1 = r * v0[2] + sh[bj][0][2], b1 = r * v0[3] + sh[bj][0][3];
                    const float a2 = r * v1[0] + sh[bj][1][0], b2 = r * v1[1] + sh[bj][1][1], a3 = r * v1[2] + sh[bj][1][2], b3 = r * v1[3] + sh[bj][1][3];
                    h16x4 o; o[0] = (h16)(silu_f(a0) * b0); o[1] = (h16)(silu_f(a1) * b1); o[2] = (h16)(silu_f(a2) * b2); o[3] = (h16)(silu_f(a3) * b3);
                    *(h16x4*)(O + (size_t)row * FF + ((col0 + bj * pg8::HALF) >> 1)) = o;
                }
            }
    }
};
template <bool IN32> struct EpiResN {
    static constexpr bool PERM = true, AFTER_DRAIN = false, IDEMPOTENT = false;
    const float* xin32; const h16* xin16; h16* xout; const float* gate; h16* XG; const float* gmod; float* ssq;
    __device__ __forceinline__ void operator()(const f32x4 (&acc)[2][2][4][2], const pg8::Unit& u, int wr, int wc, int fr, int fq) const {
        const int row00 = u.pm * pg8::BM + wr * 64 + fr, b = row00 >> 12, col0 = u.pn * pg8::BM + wc * 32 + 8 * fq;
        f32x4 gt[2][2], gm[2][2];
#pragma unroll
        for (int bj = 0; bj < 2; ++bj) {
            const float* g = gate + (size_t)b * 6144 + col0 + bj * pg8::HALF; gt[bj][0] = *(const f32x4*)g; gt[bj][1] = *(const f32x4*)(g + 4);
            const float* q = gmod + (size_t)b * 1024 + col0 + bj * pg8::HALF; gm[bj][0] = *(const f32x4*)q; gm[bj][1] = *(const f32x4*)(q + 4);
        }
#pragma unroll
        for (int ai = 0; ai < 2; ++ai)
#pragma unroll
            for (int m = 0; m < 4; ++m) {
                const int row = row00 + ai * pg8::HALF + m * 16;
                float s = 0.f;
#pragma unroll
                for (int bj = 0; bj < 2; ++bj) {
                    const int col = col0 + bj * pg8::HALF;
                    f32x4 x0, x1;
                    if (IN32) { const float* xi = xin32 + (size_t)row * DM + col; x0 = *(const f32x4*)xi; x1 = *(const f32x4*)(xi + 4); }
                    else { const h16x8 xh = *(const h16x8*)(xin16 + (size_t)row * DM + col);
#pragma unroll
                        for (int e = 0; e < 4; ++e) { x0[e] = (float)xh[e]; x1[e] = (float)xh[4 + e]; } }
                    f32x4 o0, o1;
#pragma unroll
                    for (int e = 0; e < 4; ++e) { o0[e] = x0[e] + gt[bj][0][e] * acc[ai][bj][m][0][e]; o1[e] = x1[e] + gt[bj][1][e] * acc[ai][bj][m][1][e]; }
                    h16x8 xo;
#pragma unroll
                    for (int e = 0; e < 4; ++e) { xo[e] = (h16)o0[e]; xo[4 + e] = (h16)o1[e]; }
                    *(h16x8*)(xout + (size_t)row * DM + col) = xo;
                    if (XG) {
                        h16x8 q;
#pragma unroll
                        for (int e = 0; e < 4; ++e) { q[e] = (h16)(o0[e] * gm[bj][0][e]); q[4 + e] = (h16)(o1[e] * gm[bj][1][e]); s += o0[e] * o0[e] + o1[e] * o1[e]; }
                        *(h16x8*)(XG + (size_t)row * DM + col) = q;
                    }
                }
                if (XG) {
                    { const auto r16 = __builtin_amdgcn_permlane16_swap(__float_as_uint(s), __float_as_uint(s), false, false); s = __uint_as_float(r16[0]) + __uint_as_float(r16[1]); }
                    { const auto r32 = __builtin_amdgcn_permlane32_swap(__float_as_uint(s), __float_as_uint(s), false, false); s = __uint_as_float(r32[0]) + __uint_as_float(r32[1]); }
                    if (fq == 0) atomicAdd(ssq + row, s);
                }
            }
    }
};

__device__ __forceinline__ void norm_mod_rows(const float* X, const float* gain, const float* modl  , int sh_idx, int sc_idx, h16* H, int gw, int ngw, int lane) {
    for (int rp = gw; rp < MROWS / 2; rp += ngw) {
        const int row0 = 2 * rp;
        const int b = row0 >> 12;
        f32x4 v[2][4]; float s[2] = {0.f, 0.f};
#pragma unroll
        for (int r = 0; r < 2; ++r) {
            const f32x4* xr = (const f32x4*)(X + (size_t)(row0 + r) * DM) + lane;
#pragma unroll
            for (int j = 0; j < 4; ++j) v[r][j] = xr[64 * j];
        }
#pragma unroll
        for (int r = 0; r < 2; ++r)
#pragma unroll
            for (int j = 0; j < 4; ++j) s[r] += (v[r][j].x * v[r][j].x + v[r][j].y * v[r][j].y) + (v[r][j].z * v[r][j].z + v[r][j].w * v[r][j].w);
        const float rstd0 = rsqrtf(wave_sum(s[0]) * (1.f / DM) + EPSN), rstd1 = rsqrtf(wave_sum(s[1]) * (1.f / DM) + EPSN);
        const float* shp = modl + (size_t)b * 6144 + sh_idx * 1024; const float* scp = modl + (size_t)b * 6144 + sc_idx * 1024;
#pragma unroll
        for (int j = 0; j < 4; ++j) {
            const int c0 = 4 * lane + 256 * j;
            const f32x4 g = *(const f32x4*)(gain + c0), sc = *(const f32x4*)(scp + c0), sh = *(const f32x4*)(shp + c0);
            h16x4 o0, o1;
#pragma unroll
            for (int e = 0; e < 4; ++e) { const float m = g[e] * (1.f + sc[e]); o0[e] = (h16)(v[0][j][e] * rstd0 * m + sh[e]); o1[e] = (h16)(v[1][j][e] * rstd1 * m + sh[e]); }
            *(h16x4*)(H + (size_t)row0 * DM + c0) = o0; *(h16x4*)(H + (size_t)(row0 + 1) * DM + c0) = o1;
        }
    }
}

__device__ __forceinline__ int t5_bucket(int rel) {
    const int n = rel < 0 ? -rel : rel;
    int v;
    if (n < 8) v = n; else if (n < 12) v = 8; else if (n < 16) v = 9; else if (n < 23) v = 10; else if (n < 32) v = 11;
    else if (n < 46) v = 12; else if (n < 64) v = 13; else if (n < 91) v = 14; else v = 15;
    return v + (rel > 0 ? 16 : 0);
}

template <int DQK, class Mod>
__device__ __forceinline__ void nattn_unit(LAS unsigned char* lds, const h16* Q, int qpitch, const h16* K, int kpitch, const h16* V, int vpitch,
                                           int key_lo, int key_hi, const Mod& mod, h16* O, int opitch) {
    const int tid = opaque_i((int)threadIdx.x), q = tid & 15, kk = tid >> 4, row = tid >> 5, l5 = tid & 31;
    LAS float* Ssh = (LAS float*)lds;
    float qreg[DQK];
#pragma unroll
    for (int d8 = 0; d8 < DQK / 8; ++d8) { const h16x8 t = *(const h16x8*)(Q + (size_t)q * qpitch + d8 * 8);
#pragma unroll
        for (int e = 0; e < 8; ++e) qreg[d8 * 8 + e] = (float)t[e]; }
    float m_run = -1e30f, l_run = 0.f, o0 = 0.f, o1 = 0.f;
    for (int c0 = key_lo; c0 < key_hi; c0 += 256) {
        const int nk = imin(256, key_hi - c0);
#pragma unroll 1
        for (int j = 0; j < 8; ++j) {
            const int kl = kk + 32 * j;
            if (kl < nk) {
                const int key = c0 + kl; float s;
                if (mod.skip(q, key)) s = -INFINITY;
                else {
                    const h16* kp = K + (size_t)key * kpitch; float a = 0.f;
#pragma unroll
                    for (int d8 = 0; d8 < DQK / 8; ++d8) { const h16x8 t = *(const h16x8*)(kp + d8 * 8);
#pragma unroll
                        for (int e = 0; e < 8; ++e) a += qreg[d8 * 8 + e] * (float)t[e]; }
                    s = a + mod.bias(q, key);
                }
                Ssh[q * 260 + kl] = s;
            }
        }
        __syncthreads();
        float cm = -INFINITY;
#pragma unroll
        for (int i = 0; i < 8; ++i) { const int kl = l5 + 32 * i; if (kl < nk) cm = fmaxf(cm, Ssh[row * 260 + kl]); }
#pragma unroll
        for (int o = 1; o < 32; o <<= 1) cm = fmaxf(cm, __shfl_xor(cm, o));
        const float m_new = fmaxf(m_run, cm), alpha = exp2f(m_run - m_new);
        float ps = 0.f;
#pragma unroll
        for (int i = 0; i < 8; ++i) { const int kl = l5 + 32 * i; if (kl < nk) { const float s = Ssh[row * 260 + kl]; const float p = (s == -INFINITY) ? 0.f : exp2f(s - m_new); Ssh[row * 260 + kl] = p; ps += p; } }
#pragma unroll
        for (int o = 1; o < 32; o <<= 1) ps += __shfl_xor(ps, o);
        l_run = l_run * alpha + ps; m_run = m_new;
        __syncthreads();
        o0 *= alpha; o1 *= alpha;
        const h16* vp = V + (size_t)c0 * vpitch + 2 * l5;
        for (int kl = 0; kl < nk; ++kl) {
            const float p = Ssh[row * 260 + kl];
            if (p != 0.f) { const h16x2 v2 = *(const h16x2*)(vp + (size_t)kl * vpitch); o0 += p * (float)v2[0]; o1 += p * (float)v2[1]; }
        }
        __syncthreads();
    }
    const float il = 1.f / l_run;
    h16x2 ov; ov[0] = (h16)(o0 * il); ov[1] = (h16)(o1 * il);
    *(h16x2*)(O + (size_t)row * opitch + 2 * l5) = ov;
}
struct ModNone { __device__ __forceinline__ bool skip(int, int) const { return false; } __device__ __forceinline__ float bias(int, int) const { return 0.f; } };
struct ModBand {
    const float* rel; int qpos0;
    __device__ __forceinline__ bool skip(int, int) const { return false; }
    __device__ __forceinline__ float bias(int qi, int key) const { int d = qpos0 + qi - key; d = d < -63 ? -63 : (d > 256 ? 256 : d); return rel[d + 63] * LOG2E; }
};
struct ModDsa {
    const u64* bm; const float* t5; int h; int qpos0;
    __device__ __forceinline__ bool skip(int qi, int key) const { return ((bm[(size_t)qi * 64 + (key >> 6)] >> (key & 63)) & 1ull) == 0ull; }
    __device__ __forceinline__ float bias(int qi, int key) const { return t5[t5_bucket(key - (qpos0 + qi)) * 4 + h] * LOG2E; }
};


typedef float f32x16 __attribute__((ext_vector_type(16)));
typedef short s16x4 __attribute__((ext_vector_type(4)));
__device__ __forceinline__ float max3f(float a, float b, float c) { float r; asm("v_max3_f32 %0, %1, %2, %3" : "=v"(r) : "v"(a), "v"(b), "v"(c)); return r; }

template <int DQK> struct FaGeo {
    static constexpr int KCH = DQK / 8, KP = DQK * 2 + 16, KT = 64 * KP, VT = 8192, BUF = KT + VT;
};
constexpr int FA_TAB_OFF = 45056;
constexpr float FA_THR = 8.f;
__device__ __forceinline__ h16x4 fa_tr(const LAS unsigned char* p) { return __builtin_bit_cast(h16x4, __builtin_amdgcn_ds_read_tr16_b64_v4i16((LAS s16x4*)p)); }

template <int DQK, int MODE>
__device__ __forceinline__ void fa_unit(LAS unsigned char* lds, const h16* Qw, int qpitch, const h16* Kb, int kpitch, const h16* Vb, int vpitch,
                                        int t_lo, int t_hi, int wt_lo, int wt_hi, int qpos_w, const LAS float* tab, const u64* bmrow, h16* Ow, int opitch) {
    typedef FaGeo<DQK> GEO;
    constexpr int KCH = GEO::KCH, KP = GEO::KP, KT = GEO::KT, BUF = GEO::BUF, NKS = DQK / 16;
    const int tid = opaque_i((int)threadIdx.x), lane = tid & 63, q = lane & 31, hi = lane >> 5;
    h16x8 qf[NKS];
#pragma unroll
    for (int ks = 0; ks < NKS; ++ks) qf[ks] = *(const h16x8*)(Qw + (size_t)q * qpitch + ks * 16 + hi * 8);
    const int kc0_key = tid / KCH, kc0_part = tid % KCH;
    const int kc1 = tid + 512, kc1_key = kc1 / KCH, kc1_part = kc1 % KCH;
    constexpr bool K2 = (64 * KCH > 512);
    const bool k1_on = K2 && (kc1 < 64 * KCH);
    const int v_key = tid >> 3, v_part = tid & 7;
    const size_t kg0 = (size_t)kc0_key * kpitch + kc0_part * 8, kg1 = (size_t)kc1_key * kpitch + kc1_part * 8, vg = (size_t)v_key * vpitch + v_part * 8;
    const int kl0 = kc0_key * KP + kc0_part * 16, kl1 = kc1_key * KP + kc1_part * 16, vl = KT + (v_part >> 2) * 4096 + v_key * 64 + (v_part & 3) * 16;
    const int ka_off = q * KP + hi * 16;
    const int va_off = KT + (4 * hi + ((lane & 15) >> 2)) * 64 + ((lane >> 4) & 1) * 32 + (lane & 3) * 8;
    f32x16 o0, o1;
#pragma unroll
    for (int r = 0; r < 16; ++r) { o0[r] = 0.f; o1[r] = 0.f; }
    float m_run = 0.f, l_run = 0.f; bool m_init = true;
    u32x4 ak0, ak1, av, bk0, bk1, bv;
    const int t_last = t_hi - 1;
#define FA_LOAD(K0, K1, V, tt) do { const int tc_ = imin((tt), t_last); const h16* kt_ = Kb + (size_t)tc_ * 64 * kpitch; const h16* vt_ = Vb + (size_t)tc_ * 64 * vpitch; \
        K0 = *(const u32x4*)(kt_ + kg0); if (K2) K1 = *(const u32x4*)(kt_ + (k1_on ? kg1 : kg0)); V = *(const u32x4*)(vt_ + vg); } while (0)
#define FA_STORE(K0, K1, V, boff) do { *(LAS u32x4*)(lds + (boff) + kl0) = K0; if (K2 && k1_on) *(LAS u32x4*)(lds + (boff) + kl1) = K1; *(LAS u32x4*)(lds + (boff) + vl) = V; } while (0)
    FA_LOAD(ak0, ak1, av, t_lo);
    FA_STORE(ak0, ak1, av, 0);
    FA_LOAD(ak0, ak1, av, t_lo + 1);
    u64 selw_n = 0ull;
    if (MODE == 2) selw_n = bmrow[(size_t)q * 64 + t_lo];
    __syncthreads();
    auto compute = [&](const int t, const int bo, const u64 selw) __attribute__((always_inline)) {
        if (t >= wt_lo && t < wt_hi) {
            const LAS unsigned char* kb = lds + bo;
            const int kdist = (qpos_w >> 6) - t;
            const bool nearb = (MODE >= 1) && (kdist < 5);
            f32x16 p0, p1;
            if (MODE >= 1 && nearb) {
                const LAS float* tj = tab + (382 - (qpos_w + q - 64 * t - 4 * hi + 63));
#pragma unroll
                for (int r = 0; r < 16; ++r) { const int c = (r & 3) + 8 * (r >> 2); p0[r] = tj[c] - m_run; p1[r] = tj[c + 32] - m_run; }
            } else {
                const float cinit = ((MODE >= 1) ? tab[63] : 0.f) - m_run;
#pragma unroll
                for (int r = 0; r < 16; ++r) { p0[r] = cinit; p1[r] = cinit; }
            }
            if (MODE == 2) {
                const int w0 = (int)((unsigned)(selw) >> (4 * hi)), w1 = (int)((unsigned)(selw >> 32) >> (4 * hi));
#pragma unroll
                for (int r = 0; r < 16; ++r) {
                    const int bp = (r & 3) + 8 * (r >> 2);
                    const unsigned m0 = (unsigned)__builtin_amdgcn_sbfe(w0, bp, 1), m1 = (unsigned)__builtin_amdgcn_sbfe(w1, bp, 1);
                    p0[r] = __uint_as_float((__float_as_uint(p0[r]) & m0) | (0xFF800000u & ~m0));
                    p1[r] = __uint_as_float((__float_as_uint(p1[r]) & m1) | (0xFF800000u & ~m1));
                }
            }
            {
                h16x8 kf[2 * NKS];
#pragma unroll
                for (int ks = 0; ks < NKS; ++ks) { kf[2 * ks] = *(const LAS h16x8*)(kb + ka_off + ks * 32); kf[2 * ks + 1] = *(const LAS h16x8*)(kb + ka_off + 32 * KP + ks * 32); }
                __builtin_amdgcn_sched_barrier(0);
                __builtin_amdgcn_s_setprio(1);
#pragma unroll
                for (int ks = 0; ks < NKS; ++ks) {
                    p0 = __builtin_amdgcn_mfma_f32_32x32x16_f16(kf[2 * ks], qf[ks], p0, 0, 0, 0);
                    p1 = __builtin_amdgcn_mfma_f32_32x32x16_f16(kf[2 * ks + 1], qf[ks], p1, 0, 0, 0);
                }
                __builtin_amdgcn_s_setprio(0);
            }
            h16x4 vf[2][2][2][2];
            {
                const LAS unsigned char* vbase = lds + bo + va_off;
#pragma unroll
                for (int hf = 0; hf < 2; ++hf)
#pragma unroll
                    for (int s = 0; s < 2; ++s) {
                        const int ko = (32 * hf + 16 * s) * 64;
                        vf[0][hf][s][0] = fa_tr(vbase + ko); vf[0][hf][s][1] = fa_tr(vbase + ko + 8 * 64);
                        vf[1][hf][s][0] = fa_tr(vbase + 4096 + ko); vf[1][hf][s][1] = fa_tr(vbase + 4096 + ko + 8 * 64);
                    }
                __builtin_amdgcn_sched_barrier(0);
            }
            asm volatile("s_nop 15\n\ts_nop 7" : "+v"(p0), "+v"(p1));
            float mt = max3f(p0[0], p0[1], p1[0]);
            mt = max3f(mt, p1[1], p0[2]);
#pragma unroll
            for (int r = 2; r < 15; ++r) mt = max3f(mt, p1[r], p0[r + 1]);
            mt = max3f(mt, p1[15], p1[15]);
            {
                const auto rr = __builtin_amdgcn_permlane32_swap(__float_as_uint(mt), __float_as_uint(mt), false, false);
                mt = max3f(__uint_as_float(rr[0]), __uint_as_float(rr[1]), mt);
            }
            const bool upd = (mt > -INFINITY) && (m_init || mt > FA_THR);
            if (__any(upd)) {
                const float d = upd ? mt : 0.f, alpha = __builtin_amdgcn_exp2f(-d);
                m_run += d; l_run *= alpha; m_init = m_init && !upd;
#pragma unroll
                for (int r = 0; r < 16; ++r) { p0[r] -= d; p1[r] -= d; o0[r] *= alpha; o1[r] *= alpha; }
            }
            float ps = 0.f;
#pragma unroll
            for (int r = 0; r < 16; ++r) { p0[r] = __builtin_amdgcn_exp2f(p0[r]); p1[r] = __builtin_amdgcn_exp2f(p1[r]); ps += p0[r] + p1[r]; }
            l_run += ps;
            h16x8 pa[2][2];
#pragma unroll
            for (int s = 0; s < 2; ++s)
#pragma unroll
                for (int e = 0; e < 8; ++e) { pa[0][s][e] = (h16)p0[8 * s + e]; pa[1][s][e] = (h16)p1[8 * s + e]; }
            __builtin_amdgcn_sched_barrier(0);
            __builtin_amdgcn_s_setprio(1);
#pragma unroll
            for (int hf = 0; hf < 2; ++hf)
#pragma unroll
                for (int s = 0; s < 2; ++s) {
                    const h16x4 a00 = vf[0][hf][s][0], a01 = vf[0][hf][s][1], a10 = vf[1][hf][s][0], a11 = vf[1][hf][s][1];
                    const h16x8 va0 = {a00[0], a00[1], a00[2], a00[3], a01[0], a01[1], a01[2], a01[3]};
                    const h16x8 va1 = {a10[0], a10[1], a10[2], a10[3], a11[0], a11[1], a11[2], a11[3]};
                    o0 = __builtin_amdgcn_mfma_f32_32x32x16_f16(va0, pa[hf][s], o0, 0, 0, 0);
                    o1 = __builtin_amdgcn_mfma_f32_32x32x16_f16(va1, pa[hf][s], o1, 0, 0, 0);
                }
            __builtin_amdgcn_s_setprio(0);
        }
    };
    for (int t = t_lo; t < t_hi; t += 2) {
        {
            FA_LOAD(bk0, bk1, bv, t + 2);
            const u64 selw = selw_n;
            if (MODE == 2) selw_n = bmrow[(size_t)q * 64 + imin(t + 1, t_last)];
            compute(t, 0, selw);
            FA_STORE(ak0, ak1, av, BUF);
            __syncthreads();
#if PROBE_PHASE == 16
            __syncthreads();
#endif
        }
        if (t + 1 >= t_hi) break;
        {
            FA_LOAD(ak0, ak1, av, t + 3);
            const u64 selw = selw_n;
            if (MODE == 2) selw_n = bmrow[(size_t)q * 64 + imin(t + 2, t_last)];
            compute(t + 1, BUF, selw);
            FA_STORE(bk0, bk1, bv, 0);
            __syncthreads();
#if PROBE_PHASE == 16
            __syncthreads();
#endif
        }
    }
#undef FA_LOAD
#undef FA_STORE
    const float lt = l_run + __shfl_xor(l_run, 32);
    const float il = 1.f / lt;
    h16* orow = Ow + (size_t)q * opitch + 4 * hi;
#pragma unroll
    for (int g4 = 0; g4 < 4; ++g4) {
        h16x4 a, b;
#pragma unroll
        for (int e = 0; e < 4; ++e) { a[e] = (h16)(o0[4 * g4 + e] * il); b[e] = (h16)(o1[4 * g4 + e] * il); }
        *(h16x4*)(orow + 8 * g4) = a; *(h16x4*)(orow + 32 + 8 * g4) = b;
    }
}

__device__ __forceinline__ int wave_total(int c) {
    int t = 0;
#pragma unroll
    for (int b = 0; b < 7; ++b) t += __builtin_popcountll(__ballot((c >> b) & 1)) << b;
    return t;
}
__device__ __forceinline__ unsigned ord_key(float f) { const unsigned b = __float_as_uint(f); return b ^ ((unsigned)((int)b >> 31) | 0x80000000u); }
template <int NJ>
__device__ __forceinline__ u64 select256(const float* sc, LAS unsigned* cand, int nt, int lane) {
    float f[NJ]; float s1 = 0.f, s2 = 0.f;
#pragma unroll
    for (int j = 0; j < NJ; ++j) {
        float v = -INFINITY;
        if (j < NJ - 16 || j < nt) v = sc[j * 64 + lane];
        f[j] = v;
    }
#pragma unroll
    for (int j = 0; j < NJ; ++j) if (j < NJ - 16 || j < nt) { s1 += f[j]; s2 += f[j] * f[j]; }
    constexpr float BIGF = 1152921504606846976.f;
#define SEL_GT(C, PV) do { const float pb_ = -(PV) * BIGF; float a0_ = 0.f, a1_ = 0.f, a2_ = 0.f, a3_ = 0.f; \
        _Pragma("unroll") for (int j = 0; j < NJ; j += 4) { \
            a0_ += __builtin_amdgcn_fmed3f(__builtin_fmaf(f[j], BIGF, pb_), 0.f, 1.f); a1_ += __builtin_amdgcn_fmed3f(__builtin_fmaf(f[j + 1], BIGF, pb_), 0.f, 1.f); \
            a2_ += __builtin_amdgcn_fmed3f(__builtin_fmaf(f[j + 2], BIGF, pb_), 0.f, 1.f); a3_ += __builtin_amdgcn_fmed3f(__builtin_fmaf(f[j + 3], BIGF, pb_), 0.f, 1.f); } \
        C = wave_total((int)((a0_ + a1_) + (a2_ + a3_))); } while (0)
#pragma unroll
    for (int o = 1; o < 8; o <<= 1) { s1 += __shfl_xor(s1, o); s2 += __shfl_xor(s2, o); }
    const float cntf = 8.f * (float)nt;
    const float mu = __int_as_float(__builtin_amdgcn_readfirstlane(__float_as_int(s1 / cntf)));
    const float var = __int_as_float(__builtin_amdgcn_readfirstlane(__float_as_int(s2 / cntf))) - mu * mu;
    const float sg = sqrtf(fmaxf(var, 0.f));
    float zq;
    {
        const float pq = 4.f / (float)nt;
        const float qq = pq < 0.5f ? pq : 1.f - pq;
        const float tt = sqrtf(-2.f * __logf(fmaxf(qq, 1e-6f)));
        const float zz = tt - (2.30753f + 0.27061f * tt) / (1.f + 0.99229f * tt + 0.04481f * tt * tt);
        zq = pq < 0.5f ? zz : -zz;
    }
    float flo = 0.f, fhi = 0.f; int c_lo = nt * 64, c_hi = 0; bool lo_set = false, hi_set = false;
    float step = 0.45f * sg, T = 0.f; int found = 0;
    bool ok = sg > 0.f;
    for (int iter = 0; ok && iter < 18; ++iter) {
        float pv;
        if (!lo_set && !hi_set) pv = mu + zq * sg - step;
        else if (lo_set && !hi_set) { pv = (iter == 1) ? mu + zq * sg + step : flo + step; step *= 2.f; }
        else if (!lo_set && hi_set) { pv = fhi - step; step *= 2.f; }
        else {
            float fr = (iter & 1) ? 0.5f : ((float)c_lo - 255.5f) / (float)(c_lo - c_hi);
            fr = fr < 0.06f ? 0.06f : (fr > 0.94f ? 0.94f : fr);
            pv = flo + (fhi - flo) * fr;
            if (!(pv > flo && pv < fhi)) pv = 0.5f * (flo + fhi);
            if (!(pv > flo && pv < fhi)) { ok = false; break; }
        }
        int c; SEL_GT(c, pv);
        if (c == 255 || c == 256) {
            float m = (c == 255) ? -INFINITY : INFINITY;
            if (c == 255) {
#pragma unroll
                for (int j = 0; j < NJ; ++j) m = fmaxf(m, (f[j] <= pv) ? f[j] : -INFINITY);
#pragma unroll
                for (int o = 1; o < 64; o <<= 1) m = fmaxf(m, __shfl_xor(m, o));
            } else {
#pragma unroll
                for (int j = 0; j < NJ; ++j) m = fminf(m, (f[j] > pv) ? f[j] : INFINITY);
#pragma unroll
                for (int o = 1; o < 64; o <<= 1) m = fminf(m, __shfl_xor(m, o));
            }
            T = m; found = (c == 255) ? 1 : 2; break;
        }
        if (c > 256) { flo = pv; c_lo = c; lo_set = true; } else { fhi = pv; c_hi = c; hi_set = true; }
    }
    u64 myword = 0ull;
    int c_gt = 0, c_ge = 0; unsigned Tu = 0u;
    if (found == 2) { c_ge = 256; c_gt = 0; }
    else if (found == 1) {
        const unsigned tb = __float_as_uint(T);
        const float Tp = (T > 0.f) ? __uint_as_float(tb - 1u) : (T == 0.f ? __uint_as_float(0x80000001u) : __uint_as_float(tb + 1u));
        SEL_GT(c_ge, Tp); c_gt = 255;
    }
#undef SEL_GT
    if (found && c_ge == 256) {
#pragma unroll
        for (int j = 0; j < NJ; ++j) {
            if (j < NJ - 16 || j < nt) { const u64 ge = __ballot(f[j] >= T); if (lane == j) myword = ge; }
            if ((j & 7) == 7) __builtin_amdgcn_sched_barrier(0);
        }
        return myword;
    }
    unsigned u[NJ];
#pragma unroll
    for (int j = 0; j < NJ; ++j) u[j] = (j < NJ - 16 || j < nt) ? ord_key(f[j]) : 0u;
    const u64 lt_mask = (lane == 0) ? 0ull : (~0ull >> (64 - lane));
#define SEL_COUNT(C, CND) do { C = 0; _Pragma("unroll") for (int j = 0; j < NJ; ++j) { C += __builtin_popcountll(__ballot(u[j] >= (CND))); if ((j & 7) == 7) __builtin_amdgcn_sched_barrier(0); } } while (0)
    if (found) { Tu = ord_key(T); }
    else {
        int cl = nt * 64, ch = 0, bit = 31;
        while (bit >= 0 && cl - ch > 64) {
            const unsigned cnd = Tu | (1u << bit); int c; SEL_COUNT(c, cnd);
            if (c >= 256) { Tu = cnd; cl = c; } else { ch = c; }
            --bit;
        }
        if (bit >= 0) {
            const int sh = bit + 1; int base = 0;
#pragma unroll
            for (int j = 0; j < NJ; ++j) {
                const bool inb = (((u[j] ^ Tu) >> sh) == 0u) && (j < NJ - 16 || j < nt);
                const u64 m = __ballot(inb);
                if (m) { if (inb) cand[base + __builtin_popcountll(m & lt_mask)] = u[j]; base += __builtin_popcountll(m); }
            }
            asm volatile("s_waitcnt lgkmcnt(0)" ::: "memory");
            const bool valid = lane < base; const unsigned mine = valid ? cand[lane] : 0u;
            for (; bit >= 0; --bit) {
                const unsigned cnd = Tu | (1u << bit);
                const int c = ch + __builtin_popcountll(__ballot(valid && mine >= cnd));
                if (c >= 256) Tu = cnd;
            }
        }
        { const unsigned T1 = Tu + 1u; SEL_COUNT(c_gt, T1); if (Tu == 0xFFFFFFFFu) c_gt = 0; }
    }
#undef SEL_COUNT
    int need = 256 - c_gt;
#pragma unroll
    for (int j = 0; j < NJ; ++j) {
        if (j < NJ - 16 || j < nt) {
            const u64 gt = __ballot(u[j] > Tu), eq = __ballot(u[j] == Tu);
            u64 w = gt;
            if (eq) {
                const int rank = __builtin_popcountll(eq & lt_mask);
                const u64 tk = __ballot(u[j] == Tu && rank < need);
                need -= __builtin_popcountll(tk); w |= tk;
            }
            if (lane == j) myword = w;
        }
        if ((j & 3) == 3) __builtin_amdgcn_sched_barrier(0);
    }
    return myword;
}

__device__ __forceinline__ void store_tile32(const f32x16& a, LAS unsigned char* stg, h16* gbase, int pitch, int lane) {
    const int tok = lane & 31, hi = lane >> 5;
#pragma unroll
    for (int r4 = 0; r4 < 4; ++r4) {
        h16x4 o;
#pragma unroll
        for (int e = 0; e < 4; ++e) o[e] = (h16)a[4 * r4 + e];
        *(LAS h16x4*)(stg + tok * 80 + (8 * r4 + 4 * hi) * 2) = o;
    }
    asm volatile("s_waitcnt lgkmcnt(0)" ::: "memory");
#pragma unroll
    for (int j = 0; j < 2; ++j) {
        const int tt = (lane >> 2) + 16 * j, pc = lane & 3;
        const u32x4 v = *(const LAS u32x4*)(stg + tt * 80 + pc * 16);
        *(u32x4*)(gbase + (size_t)tt * pitch + pc * 8) = v;
    }
    asm volatile("s_waitcnt lgkmcnt(0)" ::: "memory");
}

constexpr size_t SC_BATCH = 8519680;
__device__ __forceinline__ float* sc_batch(float* dout, unsigned char* ws, int b) { const int i = b & 7; return i < 7 ? dout + (size_t)i * SC_BATCH : (float*)(ws + WS_XG); }


#if PROBE_PHASE == 22
#define IDX_PROBE_MFMA() do { f32x16 d_; _Pragma("unroll") for (int r = 0; r < 16; ++r) d_[r] = 0.f; \
    _Pragma("unroll") for (int i_ = 0; i_ < 4; ++i_) _Pragma("unroll") for (int ks = 0; ks < 4; ++ks) d_ = __builtin_amdgcn_mfma_f32_32x32x16_f16(af[i_ & 1][ks], bf_[i_ >> 1][ks], d_, 0, 0, 0); \
    asm volatile("" :: "v"(d_)); } while (0)
#else
#define IDX_PROBE_MFMA() do { } while (0)
#endif
#if PROBE_PHASE == 23
#define IDX_PROBE_STORE() do { float* dz_ = (float*)(ws + (size_t)984 * MiB) + (((size_t)(bx * 8 + wave) * 4096 + (mb * 4 + nb * 2 + a) * 64 + lane) & ((size_t)8 * 1024 * 1024 - 1)); *dz_ = s_; } while (0)
#else
#define IDX_PROBE_STORE() do { } while (0)
#endif

#if PROBE_PHASE == 24
#define IDX_PROBE_VALU() do { float s2_ = 0.f; _Pragma("unroll") for (int e = 0; e < 8; ++e) s2_ += wq[mb][8 * a + e] * __builtin_amdgcn_fmed3f(c_[mb][nb][8 * a + e] + 1.f, 0.f, __builtin_inff()); asm volatile("" :: "v"(s2_)); } while (0)
#else
#define IDX_PROBE_VALU() do { } while (0)
#endif
#define LDS_BARRIER() asm volatile("s_waitcnt lgkmcnt(0)\n\ts_barrier" ::: "memory")
#define IDX_SCORE_ROUND(RND) do { PHASE_ENV(layer) \
    const h16* IKB = (const h16*)(ws + WS_IKB); \
    const int q31 = lane & 31, hi = lane >> 5; \
    constexpr int IKP = 144, ITB = 64 * IKP, ISTG = 2 * ITB;        \
    const int skey = tid >> 3, spart = tid & 7; const int sl = skey * IKP + spart * 16; \
    const int vcu_ = (G % 8 == 0) ? (bx % 8) * (G / 8) + bx / 8 : bx;        \
    for (int it = vcu_; it < 8 * 32; it += G) { \
        _Pragma("unroll 1") for (int side = 0; side < 2; ++side) { \
            const int b = (RND) * 8 + (it >> 5), cp = it & 31, c = side ? 63 - cp : cp; \
            if (c < 4) continue; \
            const size_t brow = (size_t)b * SEQ; const int t0 = c * 64 + wave * 8; \
            float* scw = sc_batch(P.out, ws, b) + (size_t)2048 * c * (c + 1) + (size_t)(wave * 8) * 64 * (c + 1); \
            h16x8 af[2][4]; float wq[2][16]; \
            { const int ql = 2 * ((q31 >> 2) & 1) + (q31 >> 4), hd = 4 * ((q31 >> 3) & 1) + (q31 & 3); \
              _Pragma("unroll") for (int mb = 0; mb < 2; ++mb) { \
                const h16* zq = Zb + (brow + t0 + 4 * mb + ql) * ZW + ZC_IDXQ + hd * 64 + hi * 8; \
                _Pragma("unroll") for (int ks = 0; ks < 4; ++ks) af[mb][ks] = *(const h16x8*)(zq + ks * 16); \
                _Pragma("unroll") for (int a = 0; a < 2; ++a) { const h16x8 w8 = *(const h16x8*)(Zb + (brow + t0 + 4 * mb + 2 * hi + a) * ZW + ZC_IDXW); \
                    _Pragma("unroll") for (int e = 0; e < 8; ++e) wq[mb][8 * a + e] = (float)w8[e]; } } } \
            const h16* kg = IKB + (brow + skey) * 64 + spart * 8; \
            const int rowp_ = 64 * (c + 1); const unsigned lane_off_ = (unsigned)(2 * hi * rowp_ + q31); \
            const int np = (c + 2) >> 1;                         \
            u32x4 ra0, ra1, rb0, rb1; \
            ra0 = *(const u32x4*)kg; ra1 = *(const u32x4*)(kg + (size_t)imin(1, c) * 4096); \
            *(LAS u32x4*)(lds + sl) = ra0; *(LAS u32x4*)(lds + ITB + sl) = ra1; \
            ra0 = *(const u32x4*)(kg + (size_t)imin(2, c) * 4096); ra1 = *(const u32x4*)(kg + (size_t)imin(3, c) * 4096); \
            LDS_BARRIER(); \
            for (int p = 0; p < np; p += 2) { \
                rb0 = *(const u32x4*)(kg + (size_t)imin(2 * p + 4, c) * 4096); rb1 = *(const u32x4*)(kg + (size_t)imin(2 * p + 5, c) * 4096); \
                IDX_SCORE_TILE(2 * p, 0); \
                if (2 * p + 1 <= c) IDX_SCORE_TILE(2 * p + 1, ITB); \
                *(LAS u32x4*)(lds + ISTG + sl) = ra0; *(LAS u32x4*)(lds + ISTG + ITB + sl) = ra1; \
                LDS_BARRIER(); \
                if (p + 1 >= np) break; \
                ra0 = *(const u32x4*)(kg + (size_t)imin(2 * p + 6, c) * 4096); ra1 = *(const u32x4*)(kg + (size_t)imin(2 * p + 7, c) * 4096); \
                IDX_SCORE_TILE(2 * p + 2, ISTG); \
                if (2 * p + 3 <= c) IDX_SCORE_TILE(2 * p + 3, ISTG + ITB); \
                *(LAS u32x4*)(lds + sl) = rb0; *(LAS u32x4*)(lds + ITB + sl) = rb1; \
                LDS_BARRIER(); \
            } \
        } \
    } } while (0)
#define IDX_SCORE_TILE(TT, BOFF) do { \
    h16x8 bf_[2][4]; \
    _Pragma("unroll") for (int nb = 0; nb < 2; ++nb) _Pragma("unroll") for (int ks = 0; ks < 4; ++ks) bf_[nb][ks] = *(const LAS h16x8*)(lds + (BOFF) + (nb * 32 + q31) * IKP + ks * 32 + hi * 16); \
    f32x16 c_[2][2]; \
    _Pragma("unroll") for (int mb = 0; mb < 2; ++mb) _Pragma("unroll") for (int nb = 0; nb < 2; ++nb) { \
        f32x16 z_; _Pragma("unroll") for (int r = 0; r < 16; ++r) z_[r] = 0.f; \
        _Pragma("unroll") for (int ks = 0; ks < 4; ++ks) z_ = __builtin_amdgcn_mfma_f32_32x32x16_f16(af[mb][ks], bf_[nb][ks], z_, 0, 0, 0); \
        c_[mb][nb] = z_; } \
    IDX_PROBE_MFMA(); \
    __builtin_amdgcn_sched_barrier(0); \
    _Pragma("unroll") for (int mb = 0; mb < 2; ++mb) _Pragma("unroll") for (int nb = 0; nb < 2; ++nb) _Pragma("unroll") for (int a = 0; a < 2; ++a) { \
        f32x2 s2_ = {0.f, 0.f}; \
        _Pragma("unroll") for (int e = 0; e < 8; e += 2) { f32x2 r2_; r2_[0] = __int_as_float(imax(__float_as_int(c_[mb][nb][8 * a + e]), 0)); r2_[1] = __int_as_float(imax(__float_as_int(c_[mb][nb][8 * a + e + 1]), 0));        \
            s2_ += (f32x2){wq[mb][8 * a + e], wq[mb][8 * a + e + 1]} * r2_; } \
        const float s_ = s2_[0] + s2_[1];                   \
        IDX_PROBE_VALU(); __builtin_nontemporal_store(s_, scw + (unsigned)((4 * mb + a) * rowp_ + (TT) * 64 + nb * 32) + lane_off_); IDX_PROBE_STORE(); } } while (0)

#define IDX_SELECT_ROUND(RND) do { PHASE_ENV(layer) \
    LAS unsigned* cand = (LAS unsigned*)lds + wave * 64; \
    for (int it = gw; it < 8 * 32 * 64; it += ngw) { \
        _Pragma("unroll 1") for (int side = 0; side < 2; ++side) { \
            const int b = (RND) * 8 + (it >> 11), cp = (it >> 6) & 31, ql = it & 63, c = side ? 63 - cp : cp, nt = c + 1; \
            const size_t row = (size_t)b * SEQ + c * 64 + ql; \
            u64 myword; \
            if (nt <= 4) myword = (lane < nt) ? ~0ull : 0ull; \
            else { const float* sc = sc_batch(P.out, ws, b) + (size_t)2048 * c * (c + 1) + (size_t)ql * 64 * (c + 1); \
                if (nt <= 16) myword = select256<16>(sc, cand, nt, lane); \
                else if (nt <= 32) myword = select256<32>(sc, cand, nt, lane); \
                else if (nt <= 48) myword = select256<48>(sc, cand, nt, lane); \
                else myword = select256<64>(sc, cand, nt, lane); } \
            BM[row * 64 + lane] = myword; \
        } \
    } } while (0)

#ifndef PROBE_PHASE
#define PROBE_PHASE -1
#endif
#define REPW(k) for (int repw_ = 0; repw_ < ((PROBE_PHASE == (k)) ? 2 : 1); ++repw_)
#define REP(k) for (int rep_ = 0; rep_ < ((PROBE_PHASE == (k)) ? 2 : 1); ++rep_, __syncthreads())
#ifndef NAIVE_GEMM
#define NAIVE_GEMM 0
#endif
#ifndef NAIVE_MLA
#define NAIVE_MLA 0
#endif
#ifndef NAIVE_TL
#define NAIVE_TL 0
#endif
#ifndef NAIVE_IDX
#define NAIVE_IDX 0
#endif
#ifndef NAIVE_BAND
#define NAIVE_BAND 0
#endif
#ifndef NAIVE_DSA_ATTN
#define NAIVE_DSA_ATTN 0
#endif
#if NAIVE_GEMM
#define RUN_GEMM(EPI, E, A_, Bt_, N_, K_) naive_gemm(lds, A_, Bt_, MROWS, N_, K_, E)
#else
#define RUN_GEMM(EPI, E, A_, Bt_, N_, K_) do { pg8::Gemm g_{A_, Bt_, MROWS, N_, K_}; pg8::StaticOrder S_; S_.init(MROWS, N_, G, bx); pg8::EpiWrap<EPI> W_{E}; \
    pg8::gemm_phase<pg8::EpiWrap<EPI>, pg8::StaticOrder, true, true>(lds, g_, S_, W_); } while (0)
#endif

constexpr int PH_PER_LAYER = 10, PH_L0 = 2, NPHASE = PH_L0 + PH_PER_LAYER * NLAYER + 1;
__global__ void __launch_bounds__(NTHR, 2) fwd(Args args) {
    extern __shared__ __attribute__((aligned(16))) unsigned char lds_raw[];
    LAS unsigned char* lds = (LAS unsigned char*)lds_raw;
    const Ptrs& P = args.p;
    const int tid = threadIdx.x;
    unsigned char* const ws0 = P.ws;
    volatile LAS unsigned* MISC = (volatile LAS unsigned*)(lds + MISC_OFF);
    for (int u = tid; u < (LDS_BYTES - MISC_OFF) / 4; u += NTHR) MISC[u] = 0u;
    __syncthreads();
    XcdBarrier bar; bar.bar = (unsigned*)(ws0 + WS_CTL) + CW_BAR; bar.x = 0; bar.st = nullptr;
    if (args.use_bar) bar = xcd_barrier_post((unsigned*)(ws0 + WS_CTL) + CW_BAR, MISC + 8);
    const int lo = args.ph_lo, hi = args.ph_hi;
#define IN(k) (lo <= (k) && (k) < hi)
#if PROBE_PHASE == 18
#define SEAM(k) do { if (IN(k) && IN((k) + 1)) { xcd_barrier(bar); xcd_barrier(bar); } } while (0)
#else
#define SEAM(k) do { if (IN(k) && IN((k) + 1)) xcd_barrier(bar); } while (0)
#endif

    if (IN(0)) { PHASE_ENV(0)
        LAS float* scr = (LAS float*)(lds + wave * 16384);
        constexpr int I_IN = 80 * 16, I_OUT = 32 * 16, I_UP = 176 * 16, I_DN = 32 * 44, I_L = I_IN + I_OUT + I_UP + I_DN;
        for (int it = gw; it < NLAYER * I_L; it += ngw) {
            const int l = it / I_L; int r = it % I_L;
            unsigned char* wl = ws + WS_W + (size_t)l * W_LAYER;
            if (r < I_IN) {
                const float* W = P.w_in + (size_t)l * DM * INW;
                const int nb = r / 16, kb = r % 16;
                cvt_item((h16*)(wl + WO_IN), DM, nb * 32, kb * 64, scr, lane, [&](int n, int k) -> float {
                    const int sc = zsrc_col(n); if (sc < 0) return 0.f;
                    const float v = W[(size_t)k * INW + sc];
                    return ((n >= ZC_CAQ && n < ZC_CAK) || (n >= ZC_SAQ && n < ZC_IDXQ)) ? v * (0.125f * LOG2E) : v; });
                continue;
            }
            r -= I_IN;
            if (r < I_OUT) {
                const float* W = P.w_out + (size_t)l * DM * DM;
                const int nb = r / 16, kb = r % 16;
                cvt_item((h16*)(wl + WO_OUT), DM, nb * 32, kb * 64, scr, lane, [&](int n, int k) -> float { return W[(size_t)k * DM + n]; });
                continue;
            }
            r -= I_OUT;
            if (r < I_UP) {
                const float* W1 = P.w1 + (size_t)l * DM * FF; const float* W3 = P.w3 + (size_t)l * DM * FF;
                const int nb = r / 16, kb = r % 16;
                cvt_item((h16*)(wl + WO_UP), DM, nb * 32, kb * 64, scr, lane, [&](int n, int k) -> float { return (n & 1) ? W3[(size_t)k * FF + (n >> 1)] : W1[(size_t)k * FF + (n >> 1)]; });
                continue;
            }
            r -= I_UP;
            {
                const float* W = P.w2 + (size_t)l * FF * DM;
                const int nb = r / 44, kb = r % 44;
                cvt_item((h16*)(wl + WO_DN), FF, nb * 32, kb * 64, scr, lane, [&](int n, int k) -> float { return W[(size_t)k * DM + n]; });
            }
        }
        {
            constexpr int J_UQ = 12 * 4, J_UKV = 16 * 2, J_PW = 8, J_L = J_UQ + J_UKV + J_PW;
            for (int it = gw; it < NLAYER * J_L; it += ngw) {
                const int l2 = it / J_L; int r = it % J_L;
                unsigned char* tl = ws + WS_TLW + (size_t)l2 * TLW_LAYER;
                if (r < J_UQ) {
                    const float* W = P.w_uq + (size_t)l2 * 256 * 384; const float* gq = P.g_cq + (size_t)l2 * 256;
                    cvt_item((h16*)(tl + TO_UQ), 256, (r / 4) * 32, (r % 4) * 64, scr, lane, [&](int n, int k) -> float { return W[(size_t)k * 384 + n] * gq[k]; });
                    continue;
                }
                r -= J_UQ;
                if (r < J_UKV) {
                    const float* W = P.w_ukv + (size_t)l2 * 128 * 512; const float* gk = P.g_ckv + (size_t)l2 * 128;
                    cvt_item((h16*)(tl + TO_UKV), 128, (r / 2) * 32, (r % 2) * 64, scr, lane, [&](int n, int k) -> float { return W[(size_t)k * 512 + n] * gk[k]; });
                    continue;
                }
                r -= J_UKV;
                {
                    const float* W = P.pool_w + (size_t)l2 * 4 * 64 * 64; const float* psc = P.pool_scale + (size_t)l2 * 256;
                    cvt_item((h16*)(tl + TO_POOL), 64, r * 32, 0, scr, lane, [&](int n, int k) -> float { return W[((size_t)(n >> 6) * 64 + k) * 64 + (n & 63)] * psc[n]; });
                }
            }
        }
        __syncthreads();
        for (int it = bx; it < NLAYER * 96; it += G) {
            const int l = it / 96, jb = it % 96;
            LAS float* sc = (LAS float*)lds + wave * 2048;
            LAS float* red = (LAS float*)lds + 8 * 2048;
            for (int i = lane; i < 2048; i += 64) { const int b = i >> 7, kk2 = i & 127; sc[i] = silu_f(P.c[b * DM + wave * 128 + kk2]); }
            asm volatile("s_waitcnt lgkmcnt(0)" ::: "memory");
            float acc[16];
#pragma unroll
            for (int b = 0; b < 16; ++b) acc[b] = 0.f;
            const float* W = P.w_mod + (size_t)l * DM * 6144 + (size_t)(wave * 128) * 6144 + jb * 64 + lane;
#pragma unroll 4
            for (int k = 0; k < 128; ++k) {
                const float w = W[(size_t)k * 6144];
#pragma unroll
                for (int b = 0; b < 16; ++b) acc[b] += sc[b * 128 + k] * w;
            }
#pragma unroll
            for (int b = 0; b < 16; ++b) red[(wave * 16 + b) * 64 + lane] = acc[b];
            __syncthreads();
            for (int o = tid; o < 1024; o += NTHR) {
                const int b = o >> 6, j = o & 63; float s = 0.f;
#pragma unroll
                for (int w = 0; w < 8; ++w) s += red[(w * 16 + b) * 64 + j];
                MOD[((size_t)l * 16 + b) * 6144 + jb * 64 + j] = s + P.b_mod[(size_t)l * 6144 + jb * 64 + j];
            }
            __syncthreads();
        }
        for (int e = bx * NTHR + tid; e < SEQ * 16; e += G * NTHR) {
            const int t = e >> 4, i = e & 15;
            const double fr = exp(-(double)i * (9.210340371976184 / 16.0));
            const double ang = (double)t * fr;
            ROPE[2 * e] = (float)cos(ang); ROPE[2 * e + 1] = (float)sin(ang);
        }
    }
    SEAM(0);

    if (IN(1)) { PHASE_ENV(0)
        float* GMOD = (float*)(ws + WS_GMOD); float* SHW = (float*)(ws + WS_SHW); float* SSQ = (float*)(ws + WS_SSQ); h16* XG = (h16*)(ws + WS_XG);
        for (int e = bx * NTHR + tid; e < NLAYER * 2 * 16 * 1024; e += G * NTHR) {
            const int d = e & 1023, b = (e >> 10) & 15, w = (e >> 14) & 1, l2 = e >> 15;
            const float g = w ? P.g_ffn[(size_t)l2 * DM + d] : P.g_mix[(size_t)l2 * DM + d];
            GMOD[e] = g * (1.f + MOD[((size_t)l2 * 16 + b) * 6144 + (w ? 4 : 1) * 1024 + d]);
        }
        for (int it = bx; it < NLAYER * 128; it += G) {
            const int l2 = it >> 7, cb = it & 127;
            LAS float* sc = (LAS float*)lds + wave * 2048;
            LAS float* red = (LAS float*)lds + 8 * 2048;
            const bool isin = cb < 40;
            for (int i = lane; i < 2048; i += 64) { const int b = i >> 7, kk2 = i & 127; sc[i] = MOD[((size_t)l2 * 16 + b) * 6144 + (isin ? 0 : 3) * 1024 + wave * 128 + kk2]; }
            asm volatile("s_waitcnt lgkmcnt(0)" ::: "memory");
            float acc[16];
#pragma unroll
            for (int b = 0; b < 16; ++b) acc[b] = 0.f;
            const float* W; size_t wstride; float wscale = 1.f; bool valid = true;
            if (isin) {
                const int n = cb * 64 + lane, sc0 = zsrc_col(n);
                valid = sc0 >= 0; W = P.w_in + (size_t)l2 * DM * INW + (valid ? sc0 : 0); wstride = INW;
                if ((n >= ZC_CAQ && n < ZC_CAK) || (n >= ZC_SAQ && n < ZC_IDXQ)) wscale = 0.125f * LOG2E;
            } else {
                const int n = (cb - 40) * 64 + lane;
                W = ((n & 1) ? P.w3 : P.w1) + (size_t)l2 * DM * FF + (n >> 1); wstride = FF;
            }
            W += (size_t)(wave * 128) * wstride;
#pragma unroll 4
            for (int k = 0; k < 128; ++k) {
                const float w = valid ? W[(size_t)k * wstride] * wscale : 0.f;
#pragma unroll
                for (int b = 0; b < 16; ++b) acc[b] += sc[b * 128 + k] * w;
            }
#pragma unroll
            for (int b = 0; b < 16; ++b) red[(wave * 16 + b) * 64 + lane] = acc[b];
            __syncthreads();
            for (int o = tid; o < 1024; o += NTHR) {
                const int b = o >> 6, j = o & 63; float s = 0.f;
#pragma unroll
                for (int w = 0; w < 8; ++w) s += red[(w * 16 + b) * 64 + j];
                SHW[((size_t)l2 * 16 + b) * 8192 + (isin ? cb * 64 : 2560 + (cb - 40) * 64) + j] = s;
            }
            __syncthreads();
        }
        for (int rp = gw; rp < MROWS / 2; rp += ngw) {
            const int row0 = 2 * rp, b = row0 >> 12;
            f32x4 v[2][4]; float s[2] = {0.f, 0.f};
#pragma unroll
            for (int r = 0; r < 2; ++r) { const f32x4* xr = (const f32x4*)(P.x + (size_t)(row0 + r) * DM) + lane;
#pragma unroll
                for (int j = 0; j < 4; ++j) v[r][j] = xr[64 * j]; }
#pragma unroll
            for (int r = 0; r < 2; ++r)
#pragma unroll
                for (int j = 0; j < 4; ++j) s[r] += (v[r][j].x * v[r][j].x + v[r][j].y * v[r][j].y) + (v[r][j].z * v[r][j].z + v[r][j].w * v[r][j].w);
            const float t0 = wave_sum(s[0]), t1 = wave_sum(s[1]);
            if (lane == 0) { SSQ[row0] = t0; SSQ[row0 + 1] = t1; }
#pragma unroll
            for (int j = 0; j < 4; ++j) {
                const int c0 = 4 * lane + 256 * j;
                const f32x4 g = *(const f32x4*)(P.g_mix + c0), sc1 = *(const f32x4*)(MOD + (size_t)b * 6144 + 1024 + c0);
                h16x4 o0, o1;
#pragma unroll
                for (int e = 0; e < 4; ++e) { const float m = g[e] * (1.f + sc1[e]); o0[e] = (h16)(v[0][j][e] * m); o1[e] = (h16)(v[1][j][e] * m); }
                *(h16x4*)(XG + (size_t)row0 * DM + c0) = o0; *(h16x4*)(XG + (size_t)(row0 + 1) * DM + c0) = o1;
            }
        }
    }
    SEAM(1);

#pragma unroll 1
    for (int layer = 0; layer < NLAYER; ++layer) {
        const int pb = PH_L0 + PH_PER_LAYER * layer;

        if (IN(pb + 0)) REP(1) { PHASE_ENV(layer) EpiZn E{Zb, ZW, (h16*)(ws + WS_IKB), (const float*)(ws + WS_SSQ) + (size_t)(2 * l) * MROWS, (const float*)(ws + WS_SHW) + (size_t)l * 16 * 8192};
            pg8::Gemm g_{(const h16*)(ws + WS_XG), (const h16*)(wl + WO_IN), MROWS, ZW, DM}; pg8::StaticOrder S_; S_.init(MROWS, ZW, G, bx);
            pg8::gemm_phase<EpiZn, pg8::StaticOrder, true, true>(lds, g_, S_, E); }
        SEAM(pb + 0);

        if (IN(pb + 1)) {
#if NAIVE_TL
            REP(2) { PHASE_ENV(layer)
                LAS float* dsh = (LAS float*)lds + wave * 256;
                const float* pw = P.pool_w + (size_t)l * 4 * 64 * 64;
                const int g = lane >> 4, win = 2 << g, c0 = 4 * lane;
                for (int row = gw; row < MROWS; row += ngw) {
                    const int t = row & (SEQ - 1);
                    const int cnt = imin(t + 1, win);
                    float s0 = 0.f, s1 = 0.f, s2 = 0.f, s3 = 0.f, u0 = 0.f, u1 = 0.f, u2 = 0.f, u3 = 0.f;
                    for (int j = 0; j < cnt; ++j) {
                        const h16x4 u = *(const h16x4*)(Zb + (size_t)(row - j) * ZW + ZC_POOL + c0);
                        if (j == 0) { u0 = (float)u[0]; u1 = (float)u[1]; u2 = (float)u[2]; u3 = (float)u[3]; }
                        s0 += (float)u[0]; s1 += (float)u[1]; s2 += (float)u[2]; s3 += (float)u[3];
                    }
                    const float ic = 1.f / (float)cnt;
                    *(LAS f32x4*)(dsh + c0) = (f32x4){s0 * ic - u0, s1 * ic - u1, s2 * ic - u2, s3 * ic - u3};
                    asm volatile("s_waitcnt lgkmcnt(0)" ::: "memory");
                    const int d0 = 4 * (lane & 15);
                    f32x4 y = {0.f, 0.f, 0.f, 0.f};
                    const float* pwg = pw + (size_t)g * 4096 + d0;
#pragma unroll 8
                    for (int c = 0; c < 64; ++c) { const float dv = dsh[g * 64 + c]; const f32x4 w = *(const f32x4*)(pwg + c * 64); y += dv * w; }
                    const f32x4 ps = *(const f32x4*)(P.pool_scale + (size_t)l * 256 + c0);
                    y = y * ps;
                    const float ss = wave_sum((y.x * y.x + y.y * y.y) + (y.z * y.z + y.w * y.w));
                    const float rstd = rsqrtf(ss * (1.f / 256.f) + EPSN);
                    const f32x4 gg = *(const f32x4*)(P.g_group + (size_t)l * DM + c0);
                    h16x4 o;
#pragma unroll
                    for (int e = 0; e < 4; ++e) o[e] = (h16)(y[e] * rstd * gg[e]);
                    *(h16x4*)(HY + (size_t)row * DM + c0) = o;
                    asm volatile("s_waitcnt lgkmcnt(0)" ::: "memory");
                }
            }
            __syncthreads();
            REP(3) { PHASE_ENV(layer)
                LAS float* cn = (LAS float*)lds + wave * 4096;
                const float* wuq = P.w_uq + (size_t)l * 256 * 384;
                const float* wukv = P.w_ukv + (size_t)l * 128 * 512;
                const float* gcq = P.g_cq + (size_t)l * 256; const float* gckv = P.g_ckv + (size_t)l * 128;
                const float qscale = 0.10206207261596577f * LOG2E;
                for (int it = gw; it < MROWS / 8; it += ngw) {
                    const int row0 = it * 8;
#pragma unroll 1
                    for (int r = 0; r < 8; ++r) {
                        const h16x4 u = *(const h16x4*)(Zb + (size_t)(row0 + r) * ZW + ZC_CQ + 4 * lane);
                        const float a0 = (float)u[0], a1 = (float)u[1], a2 = (float)u[2], a3 = (float)u[3];
                        const float rstd = rsqrtf(wave_sum((a0 * a0 + a1 * a1) + (a2 * a2 + a3 * a3)) * (1.f / 256.f) + EPSN);
                        const f32x4 gq = *(const f32x4*)(gcq + 4 * lane);
                        *(LAS f32x4*)(cn + r * 256 + 4 * lane) = (f32x4){a0 * rstd * gq.x, a1 * rstd * gq.y, a2 * rstd * gq.z, a3 * rstd * gq.w};
                    }
                    asm volatile("s_waitcnt lgkmcnt(0)" ::: "memory");
                    float acc[6][8];
#pragma unroll
                    for (int j = 0; j < 6; ++j)
#pragma unroll
                        for (int r = 0; r < 8; ++r) acc[j][r] = 0.f;
                    for (int k = 0; k < 256; ++k) {
                        float w[6];
#pragma unroll
                        for (int j = 0; j < 6; ++j) w[j] = wuq[(size_t)k * 384 + lane + 64 * j];
#pragma unroll
                        for (int r = 0; r < 8; ++r) { const float a = cn[r * 256 + k];
#pragma unroll
                            for (int j = 0; j < 6; ++j) acc[j][r] += a * w[j]; }
                    }
                    asm volatile("s_waitcnt lgkmcnt(0)" ::: "memory");
#pragma unroll
                    for (int j = 0; j < 6; ++j)
#pragma unroll
                        for (int r = 0; r < 8; ++r) cn[r * 384 + lane + 64 * j] = acc[j][r];
                    asm volatile("s_waitcnt lgkmcnt(0)" ::: "memory");
#pragma unroll 1
                    for (int r = 0; r < 8; ++r) {
                        const int t = (row0 + r) & (SEQ - 1);
#pragma unroll
                        for (int j = 0; j < 6; ++j) {
                            const int n = lane + 64 * j, hh = n / 96, dd = n % 96;
                            float v = cn[r * 384 + n];
                            if (dd >= 64) { const int i = (dd - 64) & 15; const float cs = ROPE[(t * 16 + i) * 2], sn = ROPE[(t * 16 + i) * 2 + 1];
                                const float x1 = cn[r * 384 + hh * 96 + 64 + i], x2 = cn[r * 384 + hh * 96 + 80 + i];
                                v = (dd < 80) ? (x1 * cs - x2 * sn) : (x1 * sn + x2 * cs); }
                            MQ[(size_t)(row0 + r) * MQW + n] = (h16)(v * qscale);
                        }
                    }
                    asm volatile("s_waitcnt lgkmcnt(0)" ::: "memory");
#pragma unroll 1
                    for (int r = 0; r < 8; ++r) {
                        const h16x2 u = *(const h16x2*)(Zb + (size_t)(row0 + r) * ZW + ZC_CKV + 2 * lane);
                        const float a0 = (float)u[0], a1 = (float)u[1];
                        const float rstd = rsqrtf(wave_sum(a0 * a0 + a1 * a1) * (1.f / 128.f) + EPSN);
                        cn[r * 128 + 2 * lane] = a0 * rstd * gckv[2 * lane]; cn[r * 128 + 2 * lane + 1] = a1 * rstd * gckv[2 * lane + 1];
                    }
                    asm volatile("s_waitcnt lgkmcnt(0)" ::: "memory");
                    float ak[8][8];
#pragma unroll
                    for (int j = 0; j < 8; ++j)
#pragma unroll
                        for (int r = 0; r < 8; ++r) ak[j][r] = 0.f;
                    for (int k = 0; k < 128; ++k) {
                        float w[8];
#pragma unroll
                        for (int j = 0; j < 8; ++j) w[j] = wukv[(size_t)k * 512 + lane + 64 * j];
#pragma unroll
                        for (int r = 0; r < 8; ++r) { const float a = cn[r * 128 + k];
#pragma unroll
                            for (int j = 0; j < 8; ++j) ak[j][r] += a * w[j]; }
                    }
#pragma unroll
                    for (int j = 0; j < 8; ++j)
#pragma unroll
                        for (int r = 0; r < 8; ++r) {
                            if (j & 1) MV[(size_t)(row0 + r) * MVW + (j >> 1) * 64 + lane] = (h16)ak[j][r];
                            else MK[(size_t)(row0 + r) * MKW + (j >> 1) * 96 + lane] = (h16)ak[j][r];
                        }
#pragma unroll
                    for (int e = 0; e < 4; ++e) {
                        const int idx = lane * 4 + e, r = idx >> 5, dd = idx & 31, i = dd & 15;
                        const int t = (row0 + r) & (SEQ - 1);
                        const h16* krp = Zb + (size_t)(row0 + r) * ZW + ZC_KR;
                        const float x1 = (float)krp[i], x2 = (float)krp[16 + i];
                        const float cs = ROPE[(t * 16 + i) * 2], sn = ROPE[(t * 16 + i) * 2 + 1];
                        const h16 v = (h16)((dd < 16) ? (x1 * cs - x2 * sn) : (x1 * sn + x2 * cs));
#pragma unroll
                        for (int hh = 0; hh < 4; ++hh) MK[(size_t)(row0 + r) * MKW + hh * 96 + 64 + dd] = v;
                    }
                    asm volatile("s_waitcnt lgkmcnt(0)" ::: "memory");
                }
            }
            __syncthreads();
#else
            REP(2) { PHASE_ENV(layer)
                const unsigned char* tlw = ws + WS_TLW + (size_t)l * TLW_LAYER;
                const h16* WUQ = (const h16*)(tlw + TO_UQ); const h16* WUKV = (const h16*)(tlw + TO_UKV); const h16* WPL = (const h16*)(tlw + TO_POOL);
                constexpr int WB_BYTES = 32 * 528, PW_OFF = 2 * WB_BYTES, PW_PITCH = 144;
                const int tid_outer = tid;
                for (int it0 = bx * NWAVE; it0 < MROWS / 32; it0 += G * NWAVE) {
                    const int tid = opaque_i(tid_outer), lane = tid & 63, tok = lane & 31, hi = lane >> 5;
                    const int it = it0 + wave;
                    const int row0 = it * 32, row = row0 + tok, t = row & (SEQ - 1);
                    const h16* zr = Zb + (size_t)row * ZW;
                    LAS unsigned char* stg = lds + 73728 + wave * 2560;
                    u32x4 w0, w1;
                    {
                        const int tq = opaque_i(tid);
                        u32x4 pw4[4];
#pragma unroll
                        for (int i = 0; i < 4; ++i) { const int c = tq + 512 * i, r = c >> 3, pt = c & 7; pw4[i] = *(const u32x4*)(WPL + (size_t)r * 64 + pt * 8); }
                        { const int c0 = tq, c1 = tq + 512; w0 = *(const u32x4*)(WUQ + (size_t)(c0 >> 5) * 256 + (c0 & 31) * 8); w1 = *(const u32x4*)(WUQ + (size_t)(c1 >> 5) * 256 + (c1 & 31) * 8); }
#pragma unroll
                        for (int i = 0; i < 4; ++i) { const int c = tq + 512 * i, r = c >> 3, pt = c & 7; *(LAS u32x4*)(lds + PW_OFF + r * PW_PITCH + pt * 16) = pw4[i]; }
                    }
                    __syncthreads();
                    REPW(13)
                    {
                        h16x8 dfr[4][4];
#pragma unroll
                        for (int g = 0; g < 4; ++g) {
                            const int win = 2 << g;
                            const float ic = 1.f / (float)imin(t + 1, win);
#pragma unroll
                            for (int ks = 0; ks < 4; ++ks) {
                                const h16* up = zr + ZC_POOL + g * 64 + ks * 16 + hi * 8;
                                const h16x8 u0 = *(const h16x8*)up;
                                float sm[8];
#pragma unroll
                                for (int e = 0; e < 8; ++e) sm[e] = (float)u0[e];
#pragma unroll
                                for (int jb = 1; jb < win; jb += 8) {
                                    h16x8 uj[8];
#pragma unroll
                                    for (int jj = 0; jj < 8; ++jj) if (jb + jj < win) uj[jj] = *(const h16x8*)(up - (size_t)imin(jb + jj, t) * ZW);
#pragma unroll
                                    for (int jj = 0; jj < 8; ++jj) if (jb + jj < win) {
                                        const float wj = (jb + jj <= t) ? 1.f : 0.f;
#pragma unroll
                                        for (int e = 0; e < 8; ++e) sm[e] += wj * (float)uj[jj][e];
                                    }
                                }
#pragma unroll
                                for (int e = 0; e < 8; ++e) dfr[g][ks][e] = (h16)(sm[e] * ic - (float)u0[e]);
                                asm volatile("" ::: "memory"); __builtin_amdgcn_sched_barrier(0);
                            }
                        }
                        float ss = 0.f;
#pragma unroll 1
                        for (int gm = 0; gm < 8; ++gm) {
                            f32x16 a;
#pragma unroll
                            for (int r = 0; r < 16; ++r) a[r] = 0.f;
                            const LAS unsigned char* wp = lds + PW_OFF + (gm * 32 + tok) * PW_PITCH + hi * 16;
#pragma unroll
                            for (int ks = 0; ks < 4; ++ks) {
                                const h16x8 wf = *(const LAS h16x8*)(wp + ks * 32);
                                const h16x8 df = (gm < 2) ? dfr[0][ks] : (gm < 4) ? dfr[1][ks] : (gm < 6) ? dfr[2][ks] : dfr[3][ks];
                                a = __builtin_amdgcn_mfma_f32_32x32x16_f16(wf, df, a, 0, 0, 0);
                            }
#pragma unroll
                            for (int r = 0; r < 16; ++r) ss += a[r] * a[r];
                        }
                        ss += __shfl_xor(ss, 32);
                        const float rstd = rsqrtf(ss * (1.f / 256.f) + EPSN);
                        const float* gg = P.g_group + (size_t)l * DM;
#pragma unroll 1
                        for (int gm = 0; gm < 8; ++gm) {
                            f32x16 a;
#pragma unroll
                            for (int r = 0; r < 16; ++r) a[r] = 0.f;
                            const LAS unsigned char* wp = lds + PW_OFF + (gm * 32 + tok) * PW_PITCH + hi * 16;
#pragma unroll
                            for (int ks = 0; ks < 4; ++ks) {
                                const h16x8 wf = *(const LAS h16x8*)(wp + ks * 32);
                                const h16x8 df = (gm < 2) ? dfr[0][ks] : (gm < 4) ? dfr[1][ks] : (gm < 6) ? dfr[2][ks] : dfr[3][ks];
                                a = __builtin_amdgcn_mfma_f32_32x32x16_f16(wf, df, a, 0, 0, 0);
                            }
#pragma unroll
                            for (int r4 = 0; r4 < 4; ++r4) {
                                const f32x4 gv = *(const f32x4*)(gg + gm * 32 + 8 * r4 + 4 * hi);
#pragma unroll
                                for (int e = 0; e < 4; ++e) a[4 * r4 + e] *= rstd * gv[e];
                            }
                            store_tile32(a, stg, HY + (size_t)row0 * DM + gm * 32, DM, lane);
                        }
                    }
                    REPW(14) {
                        const int row0 = opaque_i(it * 32), row = row0 + tok; const h16* zr = Zb + (size_t)row * ZW;
                        h16x8 cf[16]; float ss = 0.f;
#pragma unroll
                        for (int ks = 0; ks < 16; ++ks) { cf[ks] = *(const h16x8*)(zr + ZC_CQ + ks * 16 + hi * 8);
#pragma unroll
                            for (int e = 0; e < 8; ++e) ss += (float)cf[ks][e] * (float)cf[ks][e]; }
                        ss += __shfl_xor(ss, 32);
                        const float sc = rsqrtf(ss * (1.f / 256.f) + EPSN) * (0.10206207261596577f * LOG2E);
                        { const int c0 = tid, c1 = tid + 512; *(LAS u32x4*)(lds + (c0 >> 5) * 528 + (c0 & 31) * 16) = w0; *(LAS u32x4*)(lds + (c1 >> 5) * 528 + (c1 & 31) * 16) = w1; }
                        __syncthreads();
#pragma unroll 1
                        for (int nb = 0; nb < 12; ++nb) {
                            const int bo = (nb & 1) * WB_BYTES;
                            {
                                const int nn = imin(nb + 1, 11); const int c0 = tid, c1 = tid + 512;
                                w0 = *(const u32x4*)(WUQ + (size_t)(nn * 32 + (c0 >> 5)) * 256 + (c0 & 31) * 8); w1 = *(const u32x4*)(WUQ + (size_t)(nn * 32 + (c1 >> 5)) * 256 + (c1 & 31) * 8);
                            }
                            f32x16 a;
#pragma unroll
                            for (int r = 0; r < 16; ++r) a[r] = 0.f;
                            const LAS unsigned char* wp = lds + bo + tok * 528 + hi * 16;
#pragma unroll
                            for (int ks = 0; ks < 16; ++ks) a = __builtin_amdgcn_mfma_f32_32x32x16_f16(*(const LAS h16x8*)(wp + ks * 32), cf[ks], a, 0, 0, 0);
#pragma unroll
                            for (int r = 0; r < 16; ++r) a[r] *= sc;
                            if (nb % 3 == 2) {
#pragma unroll
                                for (int r = 0; r < 8; ++r) {
                                    const int i = (r & 3) + 8 * (r >> 2) + 4 * hi;
                                    const f32x2 cs = *(const f32x2*)(ROPE + ((size_t)t * 16 + i) * 2);
                                    const float x1 = a[r], x2 = a[r + 8];
                                    a[r] = x1 * cs[0] - x2 * cs[1]; a[r + 8] = x1 * cs[1] + x2 * cs[0];
                                }
                            }
                            store_tile32(a, stg, MQ + (size_t)row0 * MQW + nb * 32, MQW, lane);
                            { const int bn = WB_BYTES - bo; const int c0 = tid, c1 = tid + 512; *(LAS u32x4*)(lds + bn + (c0 >> 5) * 528 + (c0 & 31) * 16) = w0; *(LAS u32x4*)(lds + bn + (c1 >> 5) * 528 + (c1 & 31) * 16) = w1; }
                            __syncthreads();
                        }
                    }
                    REPW(15) {
                        const int row0 = opaque_i(it * 32), row = row0 + tok; const h16* zr = Zb + (size_t)row * ZW;
                        h16x8 cf[8]; float ss = 0.f;
#pragma unroll
                        for (int ks = 0; ks < 8; ++ks) { cf[ks] = *(const h16x8*)(zr + ZC_CKV + ks * 16 + hi * 8);
#pragma unroll
                            for (int e = 0; e < 8; ++e) ss += (float)cf[ks][e] * (float)cf[ks][e]; }
                        ss += __shfl_xor(ss, 32);
                        const float sc = rsqrtf(ss * (1.f / 128.f) + EPSN);
                        u32x4 wk = *(const u32x4*)(WUKV + (size_t)(tid >> 4) * 128 + (tid & 15) * 8);
                        *(LAS u32x4*)(lds + (tid >> 4) * 272 + (tid & 15) * 16) = wk;
                        __syncthreads();
#pragma unroll 1
                        for (int nb = 0; nb < 16; ++nb) {
                            const int bo = (nb & 1) * WB_BYTES;
                            { const int nn = imin(nb + 1, 15); wk = *(const u32x4*)(WUKV + (size_t)(nn * 32 + (tid >> 4)) * 128 + (tid & 15) * 8); }
                            f32x16 a;
#pragma unroll
                            for (int r = 0; r < 16; ++r) a[r] = 0.f;
                            const LAS unsigned char* wp = lds + bo + tok * 272 + hi * 16;
#pragma unroll
                            for (int ks = 0; ks < 8; ++ks) a = __builtin_amdgcn_mfma_f32_32x32x16_f16(*(const LAS h16x8*)(wp + ks * 32), cf[ks], a, 0, 0, 0);
                            const int hh = nb >> 2, sub = nb & 3;
#pragma unroll
                            for (int r = 0; r < 16; ++r) a[r] *= sc;
                            if (sub < 2) store_tile32(a, stg, MK + (size_t)row0 * MKW + hh * 96 + sub * 32, MKW, lane);
                            else store_tile32(a, stg, MV + (size_t)row0 * MVW + hh * 64 + (sub - 2) * 32, MVW, lane);
                            *(LAS u32x4*)(lds + (WB_BYTES - bo) + (tid >> 4) * 272 + (tid & 15) * 16) = wk;
                            __syncthreads();
                        }
                        const h16x8 x1 = *(const h16x8*)(zr + ZC_KR + 8 * hi), x2 = *(const h16x8*)(zr + ZC_KR + 16 + 8 * hi);
                        h16x8 o1, o2;
#pragma unroll
                        for (int e = 0; e < 8; ++e) {
                            const f32x2 cs = *(const f32x2*)(ROPE + ((size_t)t * 16 + 8 * hi + e) * 2);
                            const float a1 = (float)x1[e], a2 = (float)x2[e];
                            o1[e] = (h16)(a1 * cs[0] - a2 * cs[1]); o2[e] = (h16)(a1 * cs[1] + a2 * cs[0]);
                        }
#pragma unroll
                        for (int hh = 0; hh < 4; ++hh) { *(h16x8*)(MK + (size_t)row * MKW + hh * 96 + 64 + 8 * hi) = o1; *(h16x8*)(MK + (size_t)row * MKW + hh * 96 + 80 + 8 * hi) = o2; }
                    }
                }
            }
            __syncthreads();
#endif
#if NAIVE_BAND
            { PHASE_ENV(layer)
            for (int it = bx; it < NB * 64 * 4 * 4; it += G) {
                const int qg = it & 3, h = (it >> 2) & 3, ch = (it >> 4) & 63, b = it >> 10;
                const size_t brow = (size_t)b * SEQ; const int q0 = ch * 64 + qg * 16;
                ModBand mod{P.ca_rel + ((size_t)l * 4 + h) * 320, q0};
                nattn_unit<64, ModBand>(lds, Zb + (brow + q0) * ZW + ZC_CAQ + h * 64, ZW, Zb + brow * ZW + ZC_CAK + h * 64, ZW, Zb + brow * ZW + ZC_CAV + h * 64, ZW,
                                        imax(0, (ch - 8) * 64), (ch + 1) * 64, mod, HY + (brow + q0) * DM + 256 + h * 64, DM);
            }
            __syncthreads();
            }
#else
            REP(4) {
                PHASE_ENV(layer)
                LAS float* tabs = (LAS float*)(lds + FA_TAB_OFF);
                for (int i = tid; i < 4 * 384; i += NTHR) { const int hh = i / 384, j = i % 384, idx = imin(imax(382 - j, 0), 319); tabs[i] = P.ca_rel[((size_t)l * 4 + hh) * 320 + idx] * LOG2E; }
                __syncthreads();
                const int vcu = (G % 8 == 0) ? (bx % 8) * (G / 8) + bx / 8 : bx;
                for (int uu = vcu * 4; uu < NB * 4 * 16; uu += G * 4) {
#pragma unroll 1
                    for (int i4 = 0; i4 < 4; ++i4) {
                        const int u = uu + i4, cb = u & 15, bh = u >> 4, b = bh >> 2, h = bh & 3;
                        const int c = 4 * cb + (wave >> 1), qw = 64 * c + 32 * (wave & 1);
                        const size_t brow = (size_t)b * SEQ;
                        fa_unit<64, 1>(lds, Zb + (brow + qw) * ZW + ZC_CAQ + h * 64, ZW, Zb + brow * ZW + ZC_CAK + h * 64, ZW, Zb + brow * ZW + ZC_CAV + h * 64, ZW,
                                       imax(0, 4 * cb - 8), 4 * cb + 4, imax(0, c - 8), c + 1, qw, tabs + h * 384, nullptr, HY + (brow + qw) * DM + 256 + h * 64, DM);
                    }
                }
            }
            __syncthreads();
#endif
            IDX_SCORE_ROUND(0);
        }
        SEAM(pb + 1);

        if (IN(pb + 2)) REP(21) { IDX_SELECT_ROUND(0); }
        SEAM(pb + 2);
        if (IN(pb + 3)) REP(20) { IDX_SCORE_ROUND(1); }
        SEAM(pb + 3);
        if (IN(pb + 4)) REP(21) { IDX_SELECT_ROUND(1); }
        SEAM(pb + 4);

        if (IN(pb + 5)) {
#if NAIVE_MLA
            { PHASE_ENV(layer)
            for (int it = bx; it < NB * 256 * 4; it += G) {
                const int h = it & 3, qg = (it >> 2) & 255, b = it >> 10;
                const size_t brow = (size_t)b * SEQ; const int q0 = qg * 16;
                ModNone mod;
                nattn_unit<96, ModNone>(lds, MQ + (brow + q0) * MQW + h * 96, MQW, MK + brow * MKW + h * 96, MKW, MV + brow * MVW + h * 64, MVW,
                                        0, ((q0 >> 6) + 1) * 64, mod, HY + (brow + q0) * DM + 768 + h * 64, DM);
            }
            }
#else
            REP(6) {
                PHASE_ENV(layer)
                const int vcu = (G % 8 == 0) ? (bx % 8) * (G / 8) + bx / 8 : bx;
                for (int uu = vcu * 4; uu < NB * 4 * 16; uu += G * 4) {
#pragma unroll 1
                    for (int i4 = 0; i4 < 4; ++i4) {
                        const int bh = uu >> 4, s = (uu >> 2) & 3, qb = (i4 == 0) ? s : (i4 == 1) ? 15 - s : (i4 == 2) ? 7 - s : 8 + s;
                        const int b = bh >> 2, h = bh & 3;
                        const size_t brow = (size_t)b * SEQ; const int qw = qb * 256 + wave * 32;
                        fa_unit<96, 0>(lds, MQ + (brow + qw) * MQW + h * 96, MQW, MK + brow * MKW + h * 96, MKW, MV + brow * MVW + h * 64, MVW,
                                       0, 4 * qb + 4, 0, (qw >> 6) + 1, qw, nullptr, nullptr, HY + (brow + qw) * DM + 768 + h * 64, DM);
                    }
                }
            }
#endif
#if NAIVE_DSA_ATTN
            { PHASE_ENV(layer)
            for (int it = bx; it < NB * 256 * 4; it += G) {
                const int h = it & 3, qg = (it >> 2) & 255, b = it >> 10;
                const size_t brow = (size_t)b * SEQ; const int q0 = qg * 16;
                ModDsa mod{BM + (brow + q0) * 64, P.t5, h, q0};
                nattn_unit<64, ModDsa>(lds, Zb + (brow + q0) * ZW + ZC_SAQ + h * 64, ZW, Zb + brow * ZW + ZC_SAK, ZW, Zb + brow * ZW + ZC_SAV, ZW,
                                       0, ((q0 >> 6) + 1) * 64, mod, HY + (brow + q0) * DM + 512 + h * 64, DM);
            }
            }
#else
            REP(7) {
                PHASE_ENV(layer)
                __syncthreads();
                LAS float* tabs = (LAS float*)(lds + FA_TAB_OFF);
                for (int i = tid; i < 4 * 384; i += NTHR) { const int hh = i / 384, j = i % 384, idx = imin(imax(382 - j, 0), 319); tabs[i] = P.t5[t5_bucket(63 - idx) * 4 + hh] * LOG2E; }
                __syncthreads();
                const int vcu = (G % 8 == 0) ? (bx % 8) * (G / 8) + bx / 8 : bx;
                for (int uu = vcu; uu < NB * 16; uu += G) {
#pragma unroll 1
                    for (int i4 = 0; i4 < 4; ++i4) {
                        const int b = uu >> 4, s = uu & 15, qc = (i4 == 0) ? s : (i4 == 1) ? 63 - s : (i4 == 2) ? 31 - s : 32 + s;
                        const int h = wave & 3, qw = 64 * qc + 32 * (wave >> 2);
                        const size_t brow = (size_t)b * SEQ;
                        fa_unit<64, 2>(lds, Zb + (brow + qw) * ZW + ZC_SAQ + h * 64, ZW, Zb + brow * ZW + ZC_SAK, ZW, Zb + brow * ZW + ZC_SAV, ZW,
                                       0, qc + 1, 0, qc + 1, qw, tabs + h * 384, BM + (brow + qw) * 64, HY + (brow + qw) * DM + 512 + h * 64, DM);
                    }
                }
            }
#endif
        }
        SEAM(pb + 5);

        if (IN(pb + 6)) { PHASE_ENV(layer)
            for (int row = gw; row < MROWS; row += ngw) {
#pragma unroll
                for (int g = 1; g < 4; ++g) {
                    h16* yp = HY + (size_t)row * DM + g * 256 + 4 * lane;
                    const h16x4 u = *(const h16x4*)yp;
                    const float a0 = (float)u[0], a1 = (float)u[1], a2 = (float)u[2], a3 = (float)u[3];
                    const float rstd = rsqrtf(wave_sum((a0 * a0 + a1 * a1) + (a2 * a2 + a3 * a3)) * (1.f / 256.f) + EPSN);
                    const f32x4 gg = *(const f32x4*)(P.g_group + (size_t)l * DM + g * 256 + 4 * lane);
                    h16x4 o; o[0] = (h16)(a0 * rstd * gg.x); o[1] = (h16)(a1 * rstd * gg.y); o[2] = (h16)(a2 * rstd * gg.z); o[3] = (h16)(a3 * rstd * gg.w);
                    *(h16x4*)yp = o;
                }
            }
        }
        SEAM(pb + 6);

        if (IN(pb + 7)) { PHASE_ENV(layer)
            h16* X16 = (h16*)(ws + WS_X16);
            pg8::Gemm g_{HY, (const h16*)(wl + WO_OUT), MROWS, DM, DM}; pg8::StaticOrder S_; S_.init(MROWS, DM, G, bx);
            if (l == 0) {
                EpiResN<true> E{P.x, nullptr, X16, modl + 2 * 1024, (h16*)(ws + WS_XG), (const float*)(ws + WS_GMOD) + ((size_t)l * 2 + 1) * 16 * 1024, (float*)(ws + WS_SSQ) + (size_t)(2 * l + 1) * MROWS};
                pg8::gemm_phase<EpiResN<true>, pg8::StaticOrder, true, true>(lds, g_, S_, E);
            } else {
                EpiResN<false> E{nullptr, X16, X16, modl + 2 * 1024, (h16*)(ws + WS_XG), (const float*)(ws + WS_GMOD) + ((size_t)l * 2 + 1) * 16 * 1024, (float*)(ws + WS_SSQ) + (size_t)(2 * l + 1) * MROWS};
                pg8::gemm_phase<EpiResN<false>, pg8::StaticOrder, true, true>(lds, g_, S_, E);
            }
        }
        SEAM(pb + 7);

        if (IN(pb + 8)) REP(8) { PHASE_ENV(layer) EpiSwin E{HID, (const float*)(ws + WS_SSQ) + (size_t)(2 * l + 1) * MROWS, (const float*)(ws + WS_SHW) + (size_t)l * 16 * 8192 + 2560};
            pg8::Gemm g_{(const h16*)(ws + WS_XG), (const h16*)(wl + WO_UP), MROWS, FF2, DM}; pg8::StaticOrder S_; S_.init(MROWS, FF2, G, bx);
            pg8::gemm_phase<EpiSwin, pg8::StaticOrder, true, true>(lds, g_, S_, E); }
        SEAM(pb + 8);

        if (IN(pb + 9)) { PHASE_ENV(layer)
            const bool nxt = (l + 1 < NLAYER);
            h16* X16 = (h16*)(ws + WS_X16);
            EpiResN<false> E{nullptr, X16, X16, modl + 5 * 1024, nxt ? (h16*)(ws + WS_XG) : (h16*)nullptr, (const float*)(ws + WS_GMOD) + ((size_t)(nxt ? l + 1 : l) * 2 + 0) * 16 * 1024, (float*)(ws + WS_SSQ) + (size_t)(2 * (nxt ? l + 1 : l)) * MROWS};
            pg8::Gemm g_{HID, (const h16*)(wl + WO_DN), MROWS, DM, FF}; pg8::StaticOrder S_; S_.init(MROWS, DM, G, bx);
            pg8::gemm_phase<EpiResN<false>, pg8::StaticOrder, true, true>(lds, g_, S_, E);
        }
        SEAM(pb + 9);
    }

    if (IN(NPHASE - 1)) { PHASE_ENV(0)
        const h16* X16 = (const h16*)(ws + WS_X16);
        for (int rp = gw; rp < MROWS / 2; rp += ngw) {
            const int row0 = 2 * rp;
            h16x8 xh[2][2]; float s[2] = {0.f, 0.f};
#pragma unroll
            for (int r = 0; r < 2; ++r)
#pragma unroll
                for (int j = 0; j < 2; ++j) xh[r][j] = *(const h16x8*)(X16 + (size_t)(row0 + r) * DM + 8 * lane + 512 * j);
#pragma unroll
            for (int r = 0; r < 2; ++r)
#pragma unroll
                for (int j = 0; j < 2; ++j)
#pragma unroll
                    for (int e = 0; e < 8; ++e) { const float f = (float)xh[r][j][e]; s[r] += f * f; }
            const float r0 = rsqrtf(wave_sum(s[0]) * (1.f / DM) + EPSN), r1 = rsqrtf(wave_sum(s[1]) * (1.f / DM) + EPSN);
#pragma unroll
            for (int j = 0; j < 2; ++j) {
                const int c0 = 8 * lane + 512 * j;
                const f32x4 g0 = *(const f32x4*)(P.g_final + c0), g1 = *(const f32x4*)(P.g_final + c0 + 4);
                f32x4 a0, a1, b0, b1;
#pragma unroll
                for (int e = 0; e < 4; ++e) { a0[e] = (float)xh[0][j][e] * r0 * g0[e]; a1[e] = (float)xh[0][j][4 + e] * r0 * g1[e]; b0[e] = (float)xh[1][j][e] * r1 * g0[e]; b1[e] = (float)xh[1][j][4 + e] * r1 * g1[e]; }
                *(f32x4*)(P.out + (size_t)row0 * DM + c0) = a0; *(f32x4*)(P.out + (size_t)row0 * DM + c0 + 4) = a1;
                *(f32x4*)(P.out + (size_t)(row0 + 1) * DM + c0) = b0; *(f32x4*)(P.out + (size_t)(row0 + 1) * DM + c0 + 4) = b1;
            }
        }
    }
#undef IN
#undef SEAM
}

extern "C" void kernel_launch(void* const* d_in, const int* in_sizes, int n_in, void* d_out, int out_size, void* d_ws, size_t ws_size, hipStream_t stream) {
    static int grid = 0;
    if (grid == 0) {
        if (n_in != 21 || out_size != MROWS * DM || ws_size < WS_END) { fprintf(stderr, "kernel_launch: unexpected problem (n_in %d out %d ws %zu)\n", n_in, out_size, ws_size); grid = -1; return; }
        int dev = 0, cus = 0, per_cu = 0;
        if (hipGetDevice(&dev) != hipSuccess || hipDeviceGetAttribute(&cus, hipDeviceAttributeMultiprocessorCount, dev) != hipSuccess) { grid = -1; return; }
        if (hipFuncSetAttribute((const void*)fwd, hipFuncAttributeMaxDynamicSharedMemorySize, LDS_BYTES) != hipSuccess) { fprintf(stderr, "kernel_launch: hipFuncSetAttribute failed\n"); grid = -1; return; }
        if (hipOccupancyMaxActiveBlocksPerMultiprocessor(&per_cu, (const void*)fwd, NTHR, LDS_BYTES) != hipSuccess || per_cu < 1) fprintf(stderr, "kernel_launch: occupancy query says %d\n", per_cu);
        (void)hipGetLastError();
        grid = cus;
    }
    if (grid < 0) return;
    (void)hipMemsetAsync((char*)d_ws + WS_CTL, 0, CTL_ZERO_BYTES, stream);
    (void)hipMemsetAsync((char*)d_ws + WS_SSQ, 0, 1 * MiB, stream);
    Args a{};
    Ptrs& p = a.p;
    p.x = (const float*)d_in[0]; p.c = (const float*)d_in[1]; p.t5 = (const float*)d_in[2]; p.w_mod = (const float*)d_in[3]; p.b_mod = (const float*)d_in[4];
    p.g_mix = (const float*)d_in[5]; p.w_in = (const float*)d_in[6]; p.pool_w = (const float*)d_in[7]; p.pool_scale = (const float*)d_in[8]; p.ca_rel = (const float*)d_in[9];
    p.g_cq = (const float*)d_in[10]; p.g_ckv = (const float*)d_in[11]; p.w_uq = (const float*)d_in[12]; p.w_ukv = (const float*)d_in[13]; p.g_group = (const float*)d_in[14];
    p.w_out = (const float*)d_in[15]; p.g_ffn = (const float*)d_in[16]; p.w1 = (const float*)d_in[17]; p.w3 = (const float*)d_in[18]; p.w2 = (const float*)d_in[19]; p.g_final = (const float*)d_in[20];
    p.out = (float*)d_out; p.ws = (unsigned char*)d_ws;
#if MK_ONE_LAUNCH
    a.ph_lo = 0; a.ph_hi = NPHASE; a.use_bar = 1;
    hipLaunchKernelGGL(fwd, dim3(grid), dim3(NTHR), LDS_BYTES, stream, a);
#else
    for (int ph = 0; ph < NPHASE; ++ph) {
        a.ph_lo = ph; a.ph_hi = ph + 1; a.use_bar = 0;
        hipLaunchKernelGGL(fwd, dim3(grid), dim3(NTHR), LDS_BYTES, stream, a);
    }
#endif
    const hipError_t le = hipPeekAtLastError();
    if (le != hipSuccess) fprintf(stderr, "kernel_launch: launch failed: %s\n", hipGetErrorName(le));
}
```

```cpp
#include <hip/hip_runtime.h>
#include <cstdio>
#include <cstdint>

#ifndef MK_ONE_LAUNCH
#define MK_ONE_LAUNCH 1
#endif

#define GAS __attribute__((address_space(1)))
#define LAS __attribute__((address_space(3)))
typedef _Float16 h16;
typedef _Float16 h16x2 __attribute__((ext_vector_type(2)));
typedef _Float16 h16x4 __attribute__((ext_vector_type(4)));
typedef _Float16 h16x8 __attribute__((ext_vector_type(8)));
typedef float f32x4 __attribute__((ext_vector_type(4)));
typedef float f32x2 __attribute__((ext_vector_type(2)));
typedef unsigned u32x4 __attribute__((ext_vector_type(4)));
typedef unsigned long long u64;

constexpr int NB = 16, SEQ = 4096, DM = 1024, MROWS = NB * SEQ, NLAYER = 2;
constexpr int ZW = 2560, FF = 2816, FF2 = 2 * FF, INW = 2408;
constexpr int NTHR = 512, NWAVE = 8;
constexpr float EPSN = 1e-6f;
constexpr float LOG2E = 1.4426950408889634f;
constexpr int ZC_POOL = 0, ZC_CAQ = 256, ZC_CAK = 512, ZC_CAV = 768, ZC_SAQ = 1024, ZC_IDXQ = 1280, ZC_CQ = 1792, ZC_CKV = 2048, ZC_KR = 2176,
              ZC_SAK = 2208, ZC_SAV = 2304, ZC_IDXK = 2368, ZC_IDXW = 2432;
constexpr int MQW = 384, MKW = 384, MVW = 256;

constexpr size_t MiB = 1u << 20;
constexpr size_t WS_CTL = 0, CTL_ZERO_BYTES = 1 * MiB;
constexpr size_t WS_MOD = 1 * MiB;
constexpr size_t WS_ROPE = 2 * MiB;
constexpr size_t WS_W = 4 * MiB, W_LAYER = 24 * MiB;
constexpr size_t WO_IN = 0, WO_OUT = 5 * MiB, WO_UP = 7 * MiB, WO_DN = 18 * MiB;
constexpr size_t WS_TLW = 52 * MiB, TLW_LAYER = 512 * 1024;
constexpr size_t TO_UQ = 0, TO_UKV = 196608, TO_POOL = 327680;
constexpr size_t WS_SSQ = 3 * MiB;
constexpr size_t WS_SHW = 53 * MiB;
constexpr size_t WS_GMOD = 54 * MiB;
constexpr size_t WS_Z = 64 * MiB;
constexpr size_t WS_HY = 416 * MiB;
constexpr size_t WS_MQ = 544 * MiB, WS_MK = 592 * MiB, WS_MV = 640 * MiB;
constexpr size_t WS_BM = 672 * MiB;
constexpr size_t WS_IKB = 704 * MiB;
constexpr size_t WS_XG = 712 * MiB;
constexpr size_t WS_X16 = 840 * MiB;
constexpr size_t WS_END = 968 * MiB;
static_assert(WS_Z + (size_t)MROWS * FF * 2 <= WS_HY, "ws map");
static_assert(WO_DN + (size_t)DM * FF * 2 <= W_LAYER && WS_W + 2 * W_LAYER <= WS_Z, "ws map");

constexpr int CW_BAR = 4096;
constexpr int SCR_BYTES = 147456;
constexpr int MISC_OFF = SCR_BYTES;
constexpr int LDS_BYTES = SCR_BYTES + 256;

#define XB_TMO      128
#define XB_XCNT(j)  (256  + 64 * (j))
#define XB_XSUB(j)  (1280 + 64 * (j))
#define XB_XGEN(j)  (2304 + 64 * (j))
#define XB_TOP      3328
#define XB_TOPGEN   3392
#define XCD_BAR_WORDS 3456
#define XB_SPIN_CAP (1u << 23)
__device__ __forceinline__ unsigned xb_ld(unsigned* p)              { return __hip_atomic_load(p, __ATOMIC_RELAXED, __HIP_MEMORY_SCOPE_AGENT); }
__device__ __forceinline__ unsigned xb_add(unsigned* p, unsigned v) { return __hip_atomic_fetch_add(p, v, __ATOMIC_RELAXED, __HIP_MEMORY_SCOPE_AGENT); }
__device__ __forceinline__ unsigned xb_xcc_id() { return (unsigned)__builtin_amdgcn_s_getreg((3 << 11) | 20) & 0xFu; }
#define XB_SPIN(cond, bar) do { unsigned _sp = 0; while (cond) { __builtin_amdgcn_s_sleep(1); \
    if ((++_sp & 255u) == 0u) { if (xb_ld(&(bar)[XB_TMO])) break; if (_sp > XB_SPIN_CAP) { atomicAdd(&(bar)[XB_TMO], 1u); break; } } } } while (0)
struct XcdBarrier { unsigned* bar; unsigned x; volatile LAS unsigned* st; };
__device__ __forceinline__ XcdBarrier xcd_barrier_post(unsigned* bar, volatile LAS unsigned* st) {
    XcdBarrier b; b.bar = bar; b.x = xb_xcc_id(); b.st = st;
    if (threadIdx.x == 0) (void)xb_add(&bar[XB_XCNT(b.x)], 1u);
    return b;
}
__device__ __forceinline__ void xcd_barrier_complete(unsigned* bar, unsigned x, unsigned& nloc, unsigned& nx) {
    const unsigned G = gridDim.x * gridDim.y * gridDim.z;
    unsigned sum, cnt, mine, sp = 0u;
    for (;;) {
        sum = 0u; cnt = 0u; mine = 0u;
#pragma unroll
        for (unsigned j = 0; j < 16; ++j) { const unsigned c = xb_ld(&bar[XB_XCNT(j)]); sum += c; cnt += (c > 0u) ? 1u : 0u; mine = (j == x) ? c : mine; }
        if (sum == G) break;
        __builtin_amdgcn_s_sleep(1);
        if ((++sp & 255u) == 0u) { if (xb_ld(&bar[XB_TMO])) break; if (sp > XB_SPIN_CAP) { atomicAdd(&bar[XB_TMO], 1u); break; } }
    }
    nloc = mine > 0u ? mine : 1u; nx = cnt > 0u ? cnt : 1u;
}
__device__ __forceinline__ void xcd_barrier(const XcdBarrier& b) {
    asm volatile("s_waitcnt vmcnt(0)" ::: "memory");
    __syncthreads();
    if (threadIdx.x == 0) {
        unsigned* bar = b.bar;
        __builtin_amdgcn_s_waitcnt(0);
        unsigned nloc = b.st[0], nx = b.st[1];
        if (nloc == 0u) { xcd_barrier_complete(bar, b.x, nloc, nx); b.st[0] = nloc; b.st[1] = nx; }
        const unsigned old = xb_add(&bar[XB_XSUB(b.x)], 1u);
        const unsigned gen = old / nloc;
        if (old + 1u == (gen + 1u) * nloc) {
            __builtin_amdgcn_fence(__ATOMIC_RELEASE, "agent");
            asm volatile("s_waitcnt vmcnt(0)" ::: "memory");
            const unsigned og = xb_add(&bar[XB_TOP], 1u);
            const unsigned tg = og / nx;
            if (og + 1u == (tg + 1u) * nx) xb_add(&bar[XB_TOPGEN], 1u);
            else XB_SPIN(xb_ld(&bar[XB_TOPGEN]) == tg, bar);
            __builtin_amdgcn_fence(__ATOMIC_ACQUIRE, "agent");
            xb_add(&bar[XB_XGEN(b.x)], 1u);
            asm volatile("s_waitcnt vmcnt(0)" ::: "memory");
        } else {
            XB_SPIN(xb_ld(&bar[XB_XGEN(b.x)]) == gen, bar);
            __builtin_amdgcn_fence(__ATOMIC_ACQUIRE, "agent");
            asm volatile("s_waitcnt vmcnt(0)" ::: "memory");
        }
    }
    __syncthreads();
}

__device__ __forceinline__ float wave_sum(float v) {
#pragma unroll
    for (int o = 1; o < 64; o <<= 1) v += __shfl_xor(v, o);
    return v;
}
__device__ __forceinline__ float silu_f(float v) { return v * __builtin_amdgcn_rcpf(1.f + __builtin_amdgcn_exp2f(-1.4426950408889634f * v)); }
__device__ __forceinline__ int imin(int a, int b) { return a < b ? a : b; }
__device__ __forceinline__ int imax(int a, int b) { return a > b ? a : b; }

__device__ __forceinline__ int opaque_i(int v) { asm volatile("" : "+v"(v)); return v; }
__device__ __forceinline__ int opaque_s(int v) { asm volatile("" : "+s"(v)); return v; }
__device__ __forceinline__ unsigned char* opaque_p(unsigned char* p) { asm volatile("" : "+s"(p)); return p; }
#define PHASE_IDS const int tid = opaque_i((int)threadIdx.x), lane = tid & 63, wave = __builtin_amdgcn_readfirstlane(tid >> 6); const int G = opaque_s((int)gridDim.x), bx = opaque_s((int)blockIdx.x), gw = bx * NWAVE + wave, ngw = G * NWAVE; (void)tid; (void)lane; (void)wave; (void)gw; (void)ngw; (void)G; (void)bx;
#define PHASE_ENV(LL) PHASE_IDS const int l = opaque_s(LL); unsigned char* const ws = args.p.ws + (size_t)(unsigned)opaque_s(0); \
    float* const MOD = (float*)(ws + WS_MOD); float* const ROPE = (float*)(ws + WS_ROPE); h16* const Zb = (h16*)(ws + WS_Z); h16* const HID = (h16*)(ws + WS_Z); h16* const HY = (h16*)(ws + WS_HY); \
    h16* const MQ = (h16*)(ws + WS_MQ); h16* const MK = (h16*)(ws + WS_MK); h16* const MV = (h16*)(ws + WS_MV); u64* const BM = (u64*)(ws + WS_BM); \
    const float* const modl = MOD + (size_t)l * 16 * 6144; unsigned char* const wl = ws + WS_W + (size_t)l * W_LAYER; const float* const xin = (l == 0) ? P.x : (const float*)P.out; \
    (void)MOD; (void)ROPE; (void)Zb; (void)HID; (void)HY; (void)MQ; (void)MK; (void)MV; (void)BM; (void)modl; (void)wl; (void)xin;

struct Ptrs {
    const float* x; const float* c; const float* t5; const float* w_mod; const float* b_mod; const float* g_mix; const float* w_in;
    const float* pool_w; const float* pool_scale; const float* ca_rel; const float* g_cq; const float* g_ckv; const float* w_uq; const float* w_ukv;
    const float* g_group; const float* w_out; const float* g_ffn; const float* w1; const float* w3; const float* w2; const float* g_final;
    float* out; unsigned char* ws;
};
struct Args { Ptrs p; int ph_lo, ph_hi, use_bar, pad; };

__device__ __forceinline__ int zsrc_col(int n) {
    if (n < 1280) return n;
    if (n < 1792) return 1408 + (n - 1280);
    if (n < 2048) return 1992 + (n - 1792);
    if (n < 2176) return 2248 + (n - 2048);
    if (n < 2208) return 2376 + (n - 2176);
    if (n < 2272) return 1280 + (n - 2208);
    if (n < 2304) return -1;
    if (n < 2368) return 1344 + (n - 2304);
    if (n < 2432) return 1920 + (n - 2368);
    if (n < 2440) return 1984 + (n - 2432);
    return -1;
}

template <class Src>
__device__ __forceinline__ void cvt_item(h16* WT, int K, int n0, int k0, LAS float* scr, int lane, const Src& src) {
#pragma unroll 4
    for (int i = 0; i < 32; ++i) { const int kk = 2 * i + (lane >> 5); scr[kk * 33 + (lane & 31)] = src(n0 + (lane & 31), k0 + kk); }
    asm volatile("s_waitcnt lgkmcnt(0)" ::: "memory");
    const int c = lane & 7;
#pragma unroll
    for (int j = 0; j < 4; ++j) {
        const int n = (lane >> 3) + 8 * j; const LAS float* s = scr + (8 * c) * 33 + n;
        h16x8 o;
#pragma unroll
        for (int e = 0; e < 8; ++e) o[e] = (h16)s[e * 33];
        *(h16x8*)(WT + (size_t)(n0 + n) * K + k0 + 8 * c) = o;
    }
    asm volatile("s_waitcnt lgkmcnt(0)" ::: "memory");
}

template <class Epi>
__device__ __forceinline__ void naive_gemm(LAS unsigned char* lds, const h16* A, const h16* Bt, int Mr, int N, int K, const Epi& E) {
    const int tid = opaque_i((int)threadIdx.x), ty = tid >> 4, tx = tid & 15;
    LAS float* As = (LAS float*)lds;
    LAS float* Bs = As + 32 * 132;
    const int nM = Mr / 128, nN = N / 128, ntile = nM * nN;
    const int lr = tid >> 2, lc = (tid & 3) * 8;
    for (int tile = blockIdx.x; tile < ntile; tile += gridDim.x) {
        const int pm = tile / nN, pn = tile % nN;
        float acc[4][8];
#pragma unroll
        for (int i = 0; i < 4; ++i)
#pragma unroll
            for (int j = 0; j < 8; ++j) acc[i][j] = 0.f;
        const h16* Ap = A + (size_t)(pm * 128 + lr) * K + lc;
        const h16* Bp = Bt + (size_t)(pn * 128 + lr) * K + lc;
        for (int k0 = 0; k0 < K; k0 += 32) {
            const h16x8 av = *(const h16x8*)(Ap + k0), bv = *(const h16x8*)(Bp + k0);
            __syncthreads();
#pragma unroll
            for (int e = 0; e < 8; ++e) { As[(lc + e) * 132 + lr] = (float)av[e]; Bs[(lc + e) * 132 + lr] = (float)bv[e]; }
            __syncthreads();
#pragma unroll 8
            for (int k = 0; k < 32; ++k) {
                const f32x4 a = *(const LAS f32x4*)(As + k * 132 + ty * 4);
                const f32x4 b0 = *(const LAS f32x4*)(Bs + k * 132 + tx * 8), b1 = *(const LAS f32x4*)(Bs + k * 132 + tx * 8 + 4);
#pragma unroll
                for (int i = 0; i < 4; ++i) {
                    acc[i][0] += a[i] * b0[0]; acc[i][1] += a[i] * b0[1]; acc[i][2] += a[i] * b0[2]; acc[i][3] += a[i] * b0[3];
                    acc[i][4] += a[i] * b1[0]; acc[i][5] += a[i] * b1[1]; acc[i][6] += a[i] * b1[2]; acc[i][7] += a[i] * b1[3];
                }
            }
        }
#pragma unroll
        for (int i = 0; i < 4; ++i) E.emit8(pm * 128 + ty * 4 + i, pn * 128 + tx * 8, acc[i]);
    }
    __syncthreads();
}
struct EpiZ {
    h16* O; int ldo; h16* IK;
    __device__ __forceinline__ void emit8(int row, int col, const float (&v)[8]) const {
        h16x8 o;
#pragma unroll
        for (int e = 0; e < 8; ++e) o[e] = (h16)v[e];
        *(h16x8*)(O + (size_t)row * ldo + col) = o;
        if (col >= ZC_IDXK && col < ZC_IDXK + 64) *(h16x8*)(IK + (size_t)row * 64 + (col - ZC_IDXK)) = o;
    }
};
struct EpiRes {
    const float* xin; float* xout; const float* gate;
    __device__ __forceinline__ void emit8(int row, int col, const float (&v)[8]) const {
        const int b = row >> 12;
        const float* g = gate + (size_t)b * 6144 + col; const float* xi = xin + (size_t)row * DM + col; float* xo = xout + (size_t)row * DM + col;
        const f32x4 g0 = *(const f32x4*)g, g1 = *(const f32x4*)(g + 4), x0 = *(const f32x4*)xi, x1 = *(const f32x4*)(xi + 4);
        f32x4 o0, o1;
#pragma unroll
        for (int e = 0; e < 4; ++e) { o0[e] = x0[e] + g0[e] * v[e]; o1[e] = x1[e] + g1[e] * v[4 + e]; }
        *(f32x4*)xo = o0; *(f32x4*)(xo + 4) = o1;
    }
};
struct EpiSwi {
    h16* O;
    __device__ __forceinline__ void emit8(int row, int col, const float (&v)[8]) const {
        h16x4 o;
#pragma unroll
        for (int j = 0; j < 4; ++j) o[j] = (h16)(silu_f(v[2 * j]) * v[2 * j + 1]);
        *(h16x4*)(O + (size_t)row * FF + (col >> 1)) = o;
    }
};


namespace pg8 {
#define PG8_LAS __attribute__((address_space(3)))
typedef _Float16 bf16_t;
constexpr int BM = 256, BK = 64, HALF = 128, HTB = HALF * BK * 2, STAGE_BYTES = 8 * HTB, NXCD = 8, WGM = 8;
__host__ __device__ __forceinline__ int lds_byte(int r, int c) { const int st = (r >> 4) * 2 + (c >> 5), rr = r & 15, cc = c & 31, ob = rr * 64 + cc * 2; return st * 1024 + (ob ^ (((ob >> 9) & 1) << 5)); }
__host__ __device__ __forceinline__ void stage_rc(int b, int& R, int& C) { const int st = b / 1024, sb = b % 1024, swz = sb ^ (((sb >> 9) & 1) << 5); R = (st >> 1) * 16 + swz / 64; C = (st & 1) * 32 + (swz % 64) / 2; }
__host__ __device__ __forceinline__ int perm32(int rho) { const int n = rho >> 4, i = rho & 15; return 8 * (i >> 2) + 4 * n + (i & 3); }
struct Unit { int pm, pn; };
struct Gemm { const bf16_t* A; const bf16_t* Bt; int M, N, K; };
struct StaticOrder {
    int nM, nN, nwg, G, c;
    __host__ __device__ void init(int M, int N, int G_, int c_) { nM = M / BM; nN = N / BM; nwg = nM * nN; G = G_; c = c_; }
    __host__ __device__ bool next(int i, Unit& u) const {
        const long L = (long)i * G + c; if (L >= nwg) return false;
        int wgid = (int)L; { const int q = nwg / NXCD, r = nwg % NXCD, xcd = wgid % NXCD, off = wgid / NXCD; wgid = (xcd < r ? xcd * (q + 1) : r * (q + 1) + (xcd - r) * q) + off; }
        const int nig = WGM * nN, gid = wgid / nig, fm = gid * WGM, gsz = (nM - fm) < WGM ? (nM - fm) : WGM;
        u.pm = fm + ((wgid % nig) % gsz); u.pn = (wgid % nig) / gsz; return true;
    }
    __device__ __forceinline__ void a_ready(const Unit&) const {}
    __device__ __forceinline__ void done(const Unit&) const {}
};
template <class E8> struct EpiWrap {
    static constexpr bool PERM = true, AFTER_DRAIN = false, IDEMPOTENT = false;
    E8 e;
    __device__ __forceinline__ void operator()(const f32x4 (&acc)[2][2][4][2], const Unit& u, int wr, int wc, int fr, int fq) const {
#pragma unroll
        for (int ai = 0; ai < 2; ++ai)
#pragma unroll
            for (int m = 0; m < 4; ++m)
#pragma unroll
                for (int bj = 0; bj < 2; ++bj) {
                    const float v[8] = {acc[ai][bj][m][0][0], acc[ai][bj][m][0][1], acc[ai][bj][m][0][2], acc[ai][bj][m][0][3], acc[ai][bj][m][1][0], acc[ai][bj][m][1][1], acc[ai][bj][m][1][2], acc[ai][bj][m][1][3]};
                    e.emit8(u.pm * BM + ai * HALF + wr * 64 + m * 16 + fr, u.pn * BM + bj * HALF + wc * 32 + 8 * fq, v);
                }
    }
};
template <class Epi, class Sched, bool ALIGN_EPI = false, bool SP2 = false>
__device__ __forceinline__ void gemm_phase(PG8_LAS unsigned char* lds, const Gemm g, const Sched& S, const Epi& E) {
    const int tid = opaque_i((int)threadIdx.x), wid = __builtin_amdgcn_readfirstlane(tid >> 6), lane = tid & 63, wr = wid >> 2, wc = wid & 3, fr = lane & 15, fq = lane >> 4;
    const int K = g.K, nt = K / BK;
    unsigned voffA[2], voffB[2];
#pragma unroll
    for (int i = 0; i < 2; ++i) { int R, C; stage_rc(tid * 16 + i * 8192, R, C); const int Rb = Epi::PERM ? ((R & ~31) + perm32(R & 31)) : R;
        voffA[i] = (unsigned)(R * K + C) * 2u; voffB[i] = (unsigned)(Rb * K + C) * 2u; }
    const size_t kstep = (size_t)(BK * 2);
    const size_t hstep = (size_t)HALF * K * 2;
    const size_t tstep = 2 * hstep;
    const unsigned ldsw = (unsigned)wid * 1024u;
    const int aoff = lds_byte(wr * 64 + fr, fq * 8), boff = lds_byte(wc * 32 + fr, fq * 8);
#define PG8_SA(b, h) (((b) * 2 + (h)) * HTB)
#define PG8_SB(b, h) ((4 + (b) * 2 + (h)) * HTB)
#define PG8_STAGE(bufoff, gbase, voff) do { _Pragma("unroll") for (int _i = 0; _i < 2; ++_i) \
        __builtin_amdgcn_global_load_lds((const unsigned*)((const char*)(gbase) + (voff)[_i]), (PG8_LAS unsigned*)(lds + (bufoff) + ldsw + _i * 8192), 16, 0, 0); } while (0)
#define PG8_LDA(dst, b, h) do { _Pragma("unroll") for (int m = 0; m < 4; ++m) _Pragma("unroll") for (int k = 0; k < 2; ++k) dst[m][k] = *(const PG8_LAS h16x8*)(lds + PG8_SA(b, h) + aoff + m * 2048 + k * 1024); } while (0)
#define PG8_LDB(dst, b, h) do { _Pragma("unroll") for (int n = 0; n < 2; ++n) _Pragma("unroll") for (int k = 0; k < 2; ++k) dst[n][k] = *(const PG8_LAS h16x8*)(lds + PG8_SB(b, h) + boff + n * 2048 + k * 1024); } while (0)
#define PG8_MMA(ai, bj, At, Bt) do { __builtin_amdgcn_s_setprio(1); _Pragma("unroll") for (int m = 0; m < 4; ++m) _Pragma("unroll") for (int n = 0; n < 2; ++n) _Pragma("unroll") for (int k = 0; k < 2; ++k) \
        acc[ai][bj][m][n] = __builtin_amdgcn_mfma_f32_16x16x32_f16(Bt[n][k], At[m][k], acc[ai][bj][m][n], 0, 0, 0); __builtin_amdgcn_s_setprio(0); } while (0)
#define PG8_WAIT_V(n) asm volatile("s_waitcnt vmcnt(" #n ")" ::: "memory")
#define PG8_WAIT_L(n) asm volatile("s_waitcnt lgkmcnt(" #n ")" ::: "memory")
#define PG8_BAR __builtin_amdgcn_s_barrier()
#define PG8_SCHED __builtin_amdgcn_sched_barrier(0)
    Unit cur, nxt; int ui = 0;
    if (!S.next(0, cur)) return;
    f32x4 acc[2][2][4][2];
#pragma unroll
    for (int a = 0; a < 2; ++a)
#pragma unroll
        for (int b = 0; b < 2; ++b)
#pragma unroll
            for (int m = 0; m < 4; ++m)
#pragma unroll
                for (int n = 0; n < 2; ++n) acc[a][b][m][n] = (f32x4){0.f, 0.f, 0.f, 0.f};
    h16x8 At[4][2], B0[2][2], B1[2][2];
    const char* cA = (const char*)g.A + (size_t)cur.pm * tstep; const char* cB = (const char*)g.Bt + (size_t)cur.pn * tstep;
    S.a_ready(cur);
    if constexpr (SP2) {
        PG8_STAGE(PG8_SB(0, 0), cB, voffB); PG8_STAGE(PG8_SB(0, 1), cB + hstep, voffB); PG8_STAGE(PG8_SA(0, 0), cA, voffA); PG8_STAGE(PG8_SA(0, 1), cA + hstep, voffA);
        if (wr == 1) PG8_BAR;
        PG8_WAIT_V(2); PG8_BAR;
        PG8_STAGE(PG8_SB(1, 0), cB + kstep, voffB); PG8_STAGE(PG8_SA(1, 0), cA + kstep, voffA); PG8_STAGE(PG8_SB(1, 1), cB + hstep + kstep, voffB);
        PG8_WAIT_V(6); PG8_BAR;
    } else {
        PG8_STAGE(PG8_SB(0, 0), cB, voffB); PG8_STAGE(PG8_SA(0, 0), cA, voffA); PG8_STAGE(PG8_SB(0, 1), cB + hstep, voffB); PG8_STAGE(PG8_SA(0, 1), cA + hstep, voffA);
        if (wr == 1) PG8_BAR;
        PG8_WAIT_V(4); PG8_BAR;
        PG8_STAGE(PG8_SB(1, 0), cB + kstep, voffB); PG8_STAGE(PG8_SA(1, 0), cA + kstep, voffA); PG8_STAGE(PG8_SB(1, 1), cB + hstep + kstep, voffB);
        PG8_WAIT_V(6); PG8_BAR;
    }
    for (;;) {
        const bool has_next = S.next(ui + 1, nxt);
        const char* nA = has_next ? (const char*)g.A + (size_t)nxt.pm * tstep : cA; const char* nB = has_next ? (const char*)g.Bt + (size_t)nxt.pn * tstep : cB;
        for (int t = 0; t < nt; t += 2) {
            const bool last = (t == nt - 2);
            const char* a1 = cA + (size_t)(t + 1) * kstep;
            const char* a2 = last ? nA : cA + (size_t)(t + 2) * kstep; const char* b2 = last ? nB : cB + (size_t)(t + 2) * kstep;
            const char* a3 = a2 + kstep; const char* b3 = b2 + kstep;
            if (last && has_next) S.a_ready(nxt);
            if constexpr (SP2) {
            PG8_LDB(B0, 0, 0); PG8_LDB(B1, 0, 1); PG8_SCHED; PG8_LDA(At, 0, 0); PG8_STAGE(PG8_SA(1, 1), a1 + hstep, voffA);
            PG8_WAIT_V(8); PG8_WAIT_L(0); PG8_BAR; PG8_MMA(0, 0, At, B0); PG8_MMA(0, 1, At, B1); PG8_BAR; PG8_SCHED;
            PG8_LDA(At, 0, 1); PG8_STAGE(PG8_SB(0, 0), b2, voffB); PG8_STAGE(PG8_SB(0, 1), b2 + hstep, voffB); PG8_STAGE(PG8_SA(0, 0), a2, voffA);
            PG8_WAIT_V(8); PG8_WAIT_L(0); PG8_BAR; PG8_MMA(1, 0, At, B0); PG8_MMA(1, 1, At, B1); PG8_BAR; PG8_SCHED;
            PG8_LDB(B0, 1, 0); PG8_LDB(B1, 1, 1); PG8_SCHED; PG8_LDA(At, 1, 0); PG8_STAGE(PG8_SA(0, 1), a2 + hstep, voffA);
            PG8_WAIT_V(8); PG8_WAIT_L(0); PG8_BAR; PG8_MMA(0, 0, At, B0); PG8_MMA(0, 1, At, B1); PG8_BAR; PG8_SCHED;
            PG8_LDA(At, 1, 1); PG8_STAGE(PG8_SB(1, 0), b3, voffB); PG8_STAGE(PG8_SB(1, 1), b3 + hstep, voffB); PG8_STAGE(PG8_SA(1, 0), a3, voffA);
            PG8_WAIT_V(8); PG8_WAIT_L(0); PG8_BAR; PG8_MMA(1, 0, At, B0); PG8_MMA(1, 1, At, B1); PG8_BAR; PG8_SCHED;
            } else {
            PG8_LDB(B0, 0, 0); PG8_SCHED; PG8_LDA(At, 0, 0); PG8_STAGE(PG8_SA(1, 1), a1 + hstep, voffA);
            PG8_WAIT_L(8); PG8_BAR; PG8_WAIT_L(0); PG8_MMA(0, 0, At, B0); PG8_BAR; PG8_SCHED;
            PG8_LDB(B1, 0, 1); PG8_STAGE(PG8_SB(0, 0), b2, voffB);
            PG8_BAR; PG8_WAIT_L(0); PG8_MMA(0, 1, At, B1); PG8_BAR;
            PG8_LDA(At, 0, 1); PG8_STAGE(PG8_SA(0, 0), a2, voffA);
            PG8_BAR; PG8_WAIT_L(0); PG8_MMA(1, 0, At, B0); PG8_BAR; PG8_SCHED;
            PG8_STAGE(PG8_SB(0, 1), b2 + hstep, voffB);
            PG8_WAIT_V(6); PG8_BAR; PG8_MMA(1, 1, At, B1); PG8_BAR;
            PG8_LDB(B0, 1, 0); PG8_SCHED; PG8_LDA(At, 1, 0); PG8_STAGE(PG8_SA(0, 1), a2 + hstep, voffA);
            PG8_WAIT_L(8); PG8_BAR; PG8_WAIT_L(0); PG8_MMA(0, 0, At, B0); PG8_BAR; PG8_SCHED;
            PG8_LDB(B1, 1, 1); PG8_STAGE(PG8_SB(1, 0), b3, voffB);
            PG8_BAR; PG8_WAIT_L(0); PG8_MMA(0, 1, At, B1); PG8_BAR;
            PG8_LDA(At, 1, 1); PG8_STAGE(PG8_SA(1, 0), a3, voffA);
            PG8_BAR; PG8_WAIT_L(0); PG8_MMA(1, 0, At, B0); PG8_BAR; PG8_SCHED;
            PG8_STAGE(PG8_SB(1, 1), b3 + hstep, voffB);
            PG8_WAIT_V(6); PG8_BAR; PG8_MMA(1, 1, At, B1); PG8_BAR;
            }
        }
        if constexpr (ALIGN_EPI) { if (wr == 0) PG8_BAR; }
        if constexpr (!Epi::AFTER_DRAIN) { E(acc, cur, wr, wc, fr, fq);
#if PROBE_PHASE == 17
            if constexpr (Epi::IDEMPOTENT) { asm volatile("" ::: "memory"); E(acc, cur, wr, wc, fr, fq); }
#endif
            S.done(cur); }
        if (!has_next) break;
#pragma unroll
        for (int a = 0; a < 2; ++a)
#pragma unroll
            for (int b = 0; b < 2; ++b)
#pragma unroll
                for (int m = 0; m < 4; ++m)
#pragma unroll
                    for (int n = 0; n < 2; ++n) acc[a][b][m][n] = (f32x4){0.f, 0.f, 0.f, 0.f};
        cur = nxt; cA = nA; cB = nB; ++ui;
        if constexpr (ALIGN_EPI) { if (wr == 1) PG8_BAR; }
    }
    PG8_WAIT_V(0);
    if constexpr (!ALIGN_EPI) { if (wr == 0) PG8_BAR; }
    PG8_BAR;
    if constexpr (Epi::AFTER_DRAIN) { E.fused(acc, cur, wr, wc, fr, fq, lds, wid, lane); S.done(cur); }
#undef PG8_SA
#undef PG8_SB
#undef PG8_STAGE
#undef PG8_LDA
#undef PG8_LDB
#undef PG8_MMA
#undef PG8_WAIT_V
#undef PG8_WAIT_L
#undef PG8_BAR
#undef PG8_SCHED
}
}

struct EpiZn {
    static constexpr bool PERM = true, AFTER_DRAIN = false, IDEMPOTENT = true;
    h16* O; int ldo; h16* IK; const float* ssq; const float* shw;
    __device__ __forceinline__ void operator()(const f32x4 (&acc)[2][2][4][2], const pg8::Unit& u, int wr, int wc, int fr, int fq) const {
        const int row00 = u.pm * pg8::BM + wr * 64 + fr, b = row00 >> 12, col0 = u.pn * pg8::BM + wc * 32 + 8 * fq;
        f32x4 sh[2][2]; float rs[2][4];
#pragma unroll
        for (int bj = 0; bj < 2; ++bj) { const float* sp = shw + (size_t)b * 8192 + col0 + bj * pg8::HALF; sh[bj][0] = *(const f32x4*)sp; sh[bj][1] = *(const f32x4*)(sp + 4); }
#pragma unroll
        for (int ai = 0; ai < 2; ++ai)
#pragma unroll
            for (int m = 0; m < 4; ++m) rs[ai][m] = ssq[row00 + ai * pg8::HALF + m * 16];
#pragma unroll
        for (int ai = 0; ai < 2; ++ai)
#pragma unroll
            for (int m = 0; m < 4; ++m) {
                const int row = row00 + ai * pg8::HALF + m * 16;
                const float r = rsqrtf(rs[ai][m] * (1.f / DM) + EPSN);
#pragma unroll
                for (int bj = 0; bj < 2; ++bj) {
                    const int col = col0 + bj * pg8::HALF;
                    h16x8 o;
#pragma unroll
                    for (int e = 0; e < 4; ++e) { o[e] = (h16)(r * acc[ai][bj][m][0][e] + sh[bj][0][e]); o[4 + e] = (h16)(r * acc[ai][bj][m][1][e] + sh[bj][1][e]); }
                    *(h16x8*)(O + (size_t)row * ldo + col) = o;
                    if (col >= ZC_IDXK && col < ZC_IDXK + 64) *(h16x8*)(IK + (size_t)row * 64 + (col - ZC_IDXK)) = o;
                }
            }
    }
};
struct EpiSwin {
    static constexpr bool PERM = true, AFTER_DRAIN = false, IDEMPOTENT = true;
    h16* O; const float* ssq; const float* shw;
    __device__ __forceinline__ void operator()(const f32x4 (&acc)[2][2][4][2], const pg8::Unit& u, int wr, int wc, int fr, int fq) const {
        const int row00 = u.pm * pg8::BM + wr * 64 + fr, b = row00 >> 12, col0 = u.pn * pg8::BM + wc * 32 + 8 * fq;
        f32x4 sh[2][2]; float rs[2][4];
#pragma unroll
        for (int bj = 0; bj < 2; ++bj) { const float* sp = shw + (size_t)b * 8192 + col0 + bj * pg8::HALF; sh[bj][0] = *(const f32x4*)sp; sh[bj][1] = *(const f32x4*)(sp + 4); }
#pragma unroll
        for (int ai = 0; ai < 2; ++ai)
#pragma unroll
            for (int m = 0; m < 4; ++m) rs[ai][m] = ssq[row00 + ai * pg8::HALF + m * 16];
#pragma unroll
        for (int ai = 0; ai < 2; ++ai)
#pragma unroll
            for (int m = 0; m < 4; ++m) {
                const int row = row00 + ai * pg8::HALF + m * 16;
                const float r = rsqrtf(rs[ai][m] * (1.f / DM) + EPSN);
#pragma unroll
                for (int bj = 0; bj < 2; ++bj) {
                    const f32x4 v0 = acc[ai][bj][m][0], v1 = acc[ai][bj][m][1];
                    const float a0 = r * v0[0] + sh[bj][0][0], b0 = r * v0[1] + sh[bj][0][1], a1 = r * v0[2] + sh[bj][0][2], b1 = r * v0[3] + sh[bj][0][3];
                    const float a2 = r * v1[0] + sh[bj][1][0], b2 = r * v1[1] + sh[bj][1][1], a3 = r * v1[2] + sh[bj][1][2], b3 = r * v1[3] + sh[bj][1][3];
                    h16x4 o; o[0] = (h16)(silu_f(a0) * b0); o[1] = (h16)(silu_f(a1) * b1); o[2] = (h16)(silu_f(a2) * b2); o[3] = (h16)(silu_f(a3) * b3);
                    *(h16x4*)(O + (size_t)row * FF + ((col0 + bj * pg8::HALF) >> 1)) = o;
                }
            }
    }
};
template <bool IN32> struct EpiResN {
    static constexpr bool PERM = true, AFTER_DRAIN = false, IDEMPOTENT = false;
    const float* xin32; const h16* xin16; h16* xout; const float* gate; h16* XG; const float* gmod; float* ssq;
    __device__ __forceinline__ void operator()(const f32x4 (&acc)[2][2][4][2], const pg8::Unit& u, int wr, int wc, int fr, int fq) const {
        const int row00 = u.pm * pg8::BM + wr * 64 + fr, b = row00 >> 12, col0 = u.pn * pg8::BM + wc * 32 + 8 * fq;
        f32x4 gt[2][2], gm[2][2];
#pragma unroll
        for (int bj = 0; bj < 2; ++bj) {
            const float* g = gate + (size_t)b * 6144 + col0 + bj * pg8::HALF; gt[bj][0] = *(const f32x4*)g; gt[bj][1] = *(const f32x4*)(g + 4);
            const float* q = gmod + (size_t)b * 1024 + col0 + bj * pg8::HALF; gm[bj][0] = *(const f32x4*)q; gm[bj][1] = *(const f32x4*)(q + 4);
        }
#pragma unroll
        for (int ai = 0; ai < 2; ++ai)
#pragma unroll
            for (int m = 0; m < 4; ++m) {
                const int row = row00 + ai * pg8::HALF + m * 16;
                float s = 0.f;
#pragma unroll
                for (int bj = 0; bj < 2; ++bj) {
                    const int col = col0 + bj * pg8::HALF;
                    f32x4 x0, x1;
                    if (IN32) { const float* xi = xin32 + (size_t)row * DM + col; x0 = *(const f32x4*)xi; x1 = *(const f32x4*)(xi + 4); }
                    else { const h16x8 xh = *(const h16x8*)(xin16 + (size_t)row * DM + col);
#pragma unroll
                        for (int e = 0; e < 4; ++e) { x0[e] = (float)xh[e]; x1[e] = (float)xh[4 + e]; } }
                    f32x4 o0, o1;
#pragma unroll
                    for (int e = 0; e < 4; ++e) { o0[e] = x0[e] + gt[bj][0][e] * acc[ai][bj][m][0][e]; o1[e] = x1[e] + gt[bj][1][e] * acc[ai][bj][m][1][e]; }
                    h16x8 xo;
#pragma unroll
                    for (int e = 0; e < 4; ++e) { xo[e] = (h16)o0[e]; xo[4 + e] = (h16)o1[e]; }
                    *(h16x8*)(xout + (size_t)row * DM + col) = xo;
                    if (XG) {
                        h16x8 q;
#pragma unroll
                        for (int e = 0; e < 4; ++e) { q[e] = (h16)(o0[e] * gm[bj][0][e]); q[4 + e] = (h16)(o1[e] * gm[bj][1][e]); s += o0[e] * o0[e] + o1[e] * o1[e]; }
                        *(h16x8*)(XG + (size_t)row * DM + col) = q;
                    }
                }
                if (XG) {
                    { const auto r16 = __builtin_amdgcn_permlane16_swap(__float_as_uint(s), __float_as_uint(s), false, false); s = __uint_as_float(r16[0]) + __uint_as_float(r16[1]); }
                    { const auto r32 = __builtin_amdgcn_permlane32_swap(__float_as_uint(s), __float_as_uint(s), false, false); s = __uint_as_float(r32[0]) + __uint_as_float(r32[1]); }
                    if (fq == 0) atomicAdd(ssq + row, s);
                }
            }
    }
};

__device__ __forceinline__ void norm_mod_rows(const float* X, const float* gain, const float* modl  , int sh_idx, int sc_idx, h16* H, int gw, int ngw, int lane) {
    for (int rp = gw; rp < MROWS / 2; rp += ngw) {
        const int row0 = 2 * rp;
        const int b = row0 >> 12;
        f32x4 v[2][4]; float s[2] = {0.f, 0.f};
#pragma unroll
        for (int r = 0; r < 2; ++r) {
            const f32x4* xr = (const f32x4*)(X + (size_t)(row0 + r) * DM) + lane;
#pragma unroll
            for (int j = 0; j < 4; ++j) v[r][j] = xr[64 * j];
        }
#pragma unroll
        for (int r = 0; r < 2; ++r)
#pragma unroll
            for (int j = 0; j < 4; ++j) s[r] += (v[r][j].x * v[r][j].x + v[r][j].y * v[r][j].y) + (v[r][j].z * v[r][j].z + v[r][j].w * v[r][j].w);
        const float rstd0 = rsqrtf(wave_sum(s[0]) * (1.f / DM) + EPSN), rstd1 = rsqrtf(wave_sum(s[1]) * (1.f / DM) + EPSN);
        const float* shp = modl + (size_t)b * 6144 + sh_idx * 1024; const float* scp = modl + (size_t)b * 6144 + sc_idx * 1024;
#pragma unroll
        for (int j = 0; j < 4; ++j) {
            const int c0 = 4 * lane + 256 * j;
            const f32x4 g = *(const f32x4*)(gain + c0), sc = *(const f32x4*)(scp + c0), sh = *(const f32x4*)(shp + c0);
            h16x4 o0, o1;
#pragma unroll
            for (int e = 0; e < 4; ++e) { const float m = g[e] * (1.f + sc[e]); o0[e] = (h16)(v[0][j][e] * rstd0 * m + sh[e]); o1[e] = (h16)(v[1][j][e] * rstd1 * m + sh[e]); }
            *(h16x4*)(H + (size_t)row0 * DM + c0) = o0; *(h16x4*)(H + (size_t)(row0 + 1) * DM + c0) = o1;
        }
    }
}

__device__ __forceinline__ int t5_bucket(int rel) {
    const int n = rel < 0 ? -rel : rel;
    int v;
    if (n < 8) v = n; else if (n < 12) v = 8; else if (n < 16) v = 9; else if (n < 23) v = 10; else if (n < 32) v = 11;
    else if (n < 46) v = 12; else if (n < 64) v = 13; else if (n < 91) v = 14; else v = 15;
    return v + (rel > 0 ? 16 : 0);
}

template <int DQK, class Mod>
__device__ __forceinline__ void nattn_unit(LAS unsigned char* lds, const h16* Q, int qpitch, const h16* K, int kpitch, const h16* V, int vpitch,
                                           int key_lo, int key_hi, const Mod& mod, h16* O, int opitch) {
    const int tid = opaque_i((int)threadIdx.x), q = tid & 15, kk = tid >> 4, row = tid >> 5, l5 = tid & 31;
    LAS float* Ssh = (LAS float*)lds;
    float qreg[DQK];
#pragma unroll
    for (int d8 = 0; d8 < DQK / 8; ++d8) { const h16x8 t = *(const h16x8*)(Q + (size_t)q * qpitch + d8 * 8);
#pragma unroll
        for (int e = 0; e < 8; ++e) qreg[d8 * 8 + e] = (float)t[e]; }
    float m_run = -1e30f, l_run = 0.f, o0 = 0.f, o1 = 0.f;
    for (int c0 = key_lo; c0 < key_hi; c0 += 256) {
        const int nk = imin(256, key_hi - c0);
#pragma unroll 1
        for (int j = 0; j < 8; ++j) {
            const int kl = kk + 32 * j;
            if (kl < nk) {
                const int key = c0 + kl; float s;
                if (mod.skip(q, key)) s = -INFINITY;
                else {
                    const h16* kp = K + (size_t)key * kpitch; float a = 0.f;
#pragma unroll
                    for (int d8 = 0; d8 < DQK / 8; ++d8) { const h16x8 t = *(const h16x8*)(kp + d8 * 8);
#pragma unroll
                        for (int e = 0; e < 8; ++e) a += qreg[d8 * 8 + e] * (float)t[e]; }
                    s = a + mod.bias(q, key);
                }
                Ssh[q * 260 + kl] = s;
            }
        }
        __syncthreads();
        float cm = -INFINITY;
#pragma unroll
        for (int i = 0; i < 8; ++i) { const int kl = l5 + 32 * i; if (kl < nk) cm = fmaxf(cm, Ssh[row * 260 + kl]); }
#pragma unroll
        for (int o = 1; o < 32; o <<= 1) cm = fmaxf(cm, __shfl_xor(cm, o));
        const float m_new = fmaxf(m_run, cm), alpha = exp2f(m_run - m_new);
        float ps = 0.f;
#pragma unroll
        for (int i = 0; i < 8; ++i) { const int kl = l5 + 32 * i; if (kl < nk) { const float s = Ssh[row * 260 + kl]; const float p = (s == -INFINITY) ? 0.f : exp2f(s - m_new); Ssh[row * 260 + kl] = p; ps += p; } }
#pragma unroll
        for (int o = 1; o < 32; o <<= 1) ps += __shfl_xor(ps, o);
        l_run = l_run * alpha + ps; m_run = m_new;
        __syncthreads();
        o0 *= alpha; o1 *= alpha;
        const h16* vp = V + (size_t)c0 * vpitch + 2 * l5;
        for (int kl = 0; kl < nk; ++kl) {
            const float p = Ssh[row * 260 + kl];
            if (p != 0.f) { const h16x2 v2 = *(const h16x2*)(vp + (size_t)kl * vpitch); o0 += p * (float)v2[0]; o1 += p * (float)v2[1]; }
        }
        __syncthreads();
    }
    const float il = 1.f / l_run;
    h16x2 ov; ov[0] = (h16)(o0 * il); ov[1] = (h16)(o1 * il);
    *(h16x2*)(O + (size_t)row * opitch + 2 * l5) = ov;
}
struct ModNone { __device__ __forceinline__ bool skip(int, int) const { return false; } __device__ __forceinline__ float bias(int, int) const { return 0.f; } };
struct ModBand {
    const float* rel; int qpos0;
    __device__ __forceinline__ bool skip(int, int) const { return false; }
    __device__ __forceinline__ float bias(int qi, int key) const { int d = qpos0 + qi - key; d = d < -63 ? -63 : (d > 256 ? 256 : d); return rel[d + 63] * LOG2E; }
};
struct ModDsa {
    const u64* bm; const float* t5; int h; int qpos0;
    __device__ __forceinline__ bool skip(int qi, int key) const { return ((bm[(size_t)qi * 64 + (key >> 6)] >> (key & 63)) & 1ull) == 0ull; }
    __device__ __forceinline__ float bias(int qi, int key) const { return t5[t5_bucket(key - (qpos0 + qi)) * 4 + h] * LOG2E; }
};


typedef float f32x16 __attribute__((ext_vector_type(16)));
typedef short s16x4 __attribute__((ext_vector_type(4)));
__device__ __forceinline__ float max3f(float a, float b, float c) { float r; asm("v_max3_f32 %0, %1, %2, %3" : "=v"(r) : "v"(a), "v"(b), "v"(c)); return r; }

template <int DQK> struct FaGeo {
    static constexpr int KCH = DQK / 8, KP = DQK * 2 + 16, KT = 64 * KP, VT = 8192, BUF = KT + VT;
};
constexpr int FA_TAB_OFF = 65536;
constexpr float FA_THR = 8.f;
__device__ __forceinline__ h16x4 fa_tr(const LAS unsigned char* p) { return __builtin_bit_cast(h16x4, __builtin_amdgcn_ds_read_tr16_b64_v4i16((LAS s16x4*)p)); }

template <int DQK, int MODE>
__device__ __forceinline__ void fa_unit(LAS unsigned char* lds, const h16* Qw, int qpitch, const h16* Kb, int kpitch, const h16* Vb, int vpitch,
                                        int t_lo, int t_hi, int wt_lo, int wt_hi, int qpos_w, const LAS float* tab, const u64* bmrow, h16* Ow, int opitch) {
    typedef FaGeo<DQK> GEO;
    constexpr int KCH = GEO::KCH, KP = GEO::KP, KT = GEO::KT, BUF = GEO::BUF, NKS = DQK / 16;
    const int tid = opaque_i((int)threadIdx.x), lane = tid & 63, q = lane & 31, hi = lane >> 5;
    h16x8 qf[NKS];
#pragma unroll
    for (int ks = 0; ks < NKS; ++ks) qf[ks] = *(const h16x8*)(Qw + (size_t)q * qpitch + ks * 16 + hi * 8);
    const int kc0_key = tid / KCH, kc0_part = tid % KCH;
    const int kc1 = tid + 512, kc1_key = kc1 / KCH, kc1_part = kc1 % KCH;
    constexpr bool K2 = (64 * KCH > 512);
    const bool k1_on = K2 && (kc1 < 64 * KCH);
    const int v_key = tid >> 3, v_part = tid & 7;
    const size_t kg0 = (size_t)kc0_key * kpitch + kc0_part * 8, kg1 = (size_t)kc1_key * kpitch + kc1_part * 8, vg = (size_t)v_key * vpitch + v_part * 8;
    const int kl0 = kc0_key * KP + kc0_part * 16, kl1 = kc1_key * KP + kc1_part * 16, vl = KT + (v_part >> 2) * 4096 + v_key * 64 + (v_part & 3) * 16;
    const int ka_off = q * KP + hi * 16;
    const int va_off = KT + (4 * hi + ((lane & 15) >> 2)) * 64 + ((lane >> 4) & 1) * 32 + (lane & 3) * 8;
    f32x16 o0, o1;
#pragma unroll
    for (int r = 0; r < 16; ++r) { o0[r] = 0.f; o1[r] = 0.f; }
    float m_run = 0.f, l_run = 0.f; bool m_init = true;
    u32x4 ak0, ak1, av, bk0, bk1, bv;
    const int t_last = t_hi - 1;
#define FA_LOAD(K0, K1, V, tt) do { const int tc_ = imin((tt), t_last); const h16* kt_ = Kb + (size_t)tc_ * 64 * kpitch; const h16* vt_ = Vb + (size_t)tc_ * 64 * vpitch; \
        K0 = *(const u32x4*)(kt_ + kg0); if (K2) K1 = *(const u32x4*)(kt_ + (k1_on ? kg1 : kg0)); V = *(const u32x4*)(vt_ + vg); } while (0)
#define FA_STORE(K0, K1, V, boff) do { *(LAS u32x4*)(lds + (boff) + kl0) = K0; if (K2 && k1_on) *(LAS u32x4*)(lds + (boff) + kl1) = K1; *(LAS u32x4*)(lds + (boff) + vl) = V; } while (0)
    FA_LOAD(ak0, ak1, av, t_lo);
    FA_STORE(ak0, ak1, av, 0);
    FA_LOAD(ak0, ak1, av, t_lo + 1);
    u64 selw_n = 0ull;
    if (MODE == 2) selw_n = bmrow[(size_t)q * 64 + t_lo];
    __syncthreads();
    auto compute = [&](const int t, const int bo, const u64 selw) __attribute__((always_inline)) {
        if (t >= wt_lo && t < wt_hi) {
            const LAS unsigned char* kb = lds + bo;
            const int kdist = (qpos_w >> 6) - t;
            const bool nearb = (MODE >= 1) && (kdist < 5);
            f32x16 p0, p1;
            if (MODE >= 1 && nearb) {
                const LAS float* tj = tab + (382 - (qpos_w + q - 64 * t - 4 * hi + 63));
#pragma unroll
                for (int r = 0; r < 16; ++r) { const int c = (r & 3) + 8 * (r >> 2); p0[r] = tj[c] - m_run; p1[r] = tj[c + 32] - m_run; }
            } else {
                const float cinit = ((MODE >= 1) ? tab[63] : 0.f) - m_run;
#pragma unroll
                for (int r = 0; r < 16; ++r) { p0[r] = cinit; p1[r] = cinit; }
            }
            if (MODE == 2) {
                const int w0 = (int)((unsigned)(selw) >> (4 * hi)), w1 = (int)((unsigned)(selw >> 32) >> (4 * hi));
#pragma unroll
                for (int r = 0; r < 16; ++r) {
                    const int bp = (r & 3) + 8 * (r >> 2);
                    const unsigned m0 = (unsigned)__builtin_amdgcn_sbfe(w0, bp, 1), m1 = (unsigned)__builtin_amdgcn_sbfe(w1, bp, 1);
                    p0[r] = __uint_as_float((__float_as_uint(p0[r]) & m0) | (0xFF800000u & ~m0));
                    p1[r] = __uint_as_float((__float_as_uint(p1[r]) & m1) | (0xFF800000u & ~m1));
                }
            }
            {
                h16x8 kf[2 * NKS];
#pragma unroll
                for (int ks = 0; ks < NKS; ++ks) { kf[2 * ks] = *(const LAS h16x8*)(kb + ka_off + ks * 32); kf[2 * ks + 1] = *(const LAS h16x8*)(kb + ka_off + 32 * KP + ks * 32); }
                __builtin_amdgcn_sched_barrier(0);
                __builtin_amdgcn_s_setprio(1);
#pragma unroll
                for (int ks = 0; ks < NKS; ++ks) {
                    p0 = __builtin_amdgcn_mfma_f32_32x32x16_f16(kf[2 * ks], qf[ks], p0, 0, 0, 0);
                    p1 = __builtin_amdgcn_mfma_f32_32x32x16_f16(kf[2 * ks + 1], qf[ks], p1, 0, 0, 0);
                }
                __builtin_amdgcn_s_setprio(0);
            }
            h16x4 vf[2][2][2][2];
            {
                const LAS unsigned char* vbase = lds + bo + va_off;
#pragma unroll
                for (int hf = 0; hf < 2; ++hf)
#pragma unroll
                    for (int s = 0; s < 2; ++s) {
                        const int ko = (32 * hf + 16 * s) * 64;
                        vf[0][hf][s][0] = fa_tr(vbase + ko); vf[0][hf][s][1] = fa_tr(vbase + ko + 8 * 64);
                        vf[1][hf][s][0] = fa_tr(vbase + 4096 + ko); vf[1][hf][s][1] = fa_tr(vbase + 4096 + ko + 8 * 64);
                    }
                __builtin_amdgcn_sched_barrier(0);
            }
            asm volatile("s_nop 15\n\ts_nop 7" : "+v"(p0), "+v"(p1));
            float mt = max3f(p0[0], p0[1], p1[0]);
            mt = max3f(mt, p1[1], p0[2]);
#pragma unroll
            for (int r = 2; r < 15; ++r) mt = max3f(mt, p1[r], p0[r + 1]);
            mt = max3f(mt, p1[15], p1[15]);
            {
                const auto rr = __builtin_amdgcn_permlane32_swap(__float_as_uint(mt), __float_as_uint(mt), false, false);
                mt = max3f(__uint_as_float(rr[0]), __uint_as_float(rr[1]), mt);
            }
            const bool upd = (mt > -INFINITY) && (m_init || mt > FA_THR);
            if (__any(upd)) {
                const float d = upd ? mt : 0.f, alpha = __builtin_amdgcn_exp2f(-d);
                m_run += d; l_run *= alpha; m_init = m_init && !upd;
#pragma unroll
                for (int r = 0; r < 16; ++r) { p0[r] -= d; p1[r] -= d; o0[r] *= alpha; o1[r] *= alpha; }
            }
            float ps = 0.f;
#pragma unroll
            for (int r = 0; r < 16; ++r) { p0[r] = __builtin_amdgcn_exp2f(p0[r]); p1[r] = __builtin_amdgcn_exp2f(p1[r]); ps += p0[r] + p1[r]; }
            l_run += ps;
            h16x8 pa[2][2];
#pragma unroll
            for (int s = 0; s < 2; ++s)
#pragma unroll
                for (int e = 0; e < 8; ++e) { pa[0][s][e] = (h16)p0[8 * s + e]; pa[1][s][e] = (h16)p1[8 * s + e]; }
            __builtin_amdgcn_sched_barrier(0);
            __builtin_amdgcn_s_setprio(1);
#pragma unroll
            for (int hf = 0; hf < 2; ++hf)
#pragma unroll
                for (int s = 0; s < 2; ++s) {
                    const h16x4 a00 = vf[0][hf][s][0], a01 = vf[0][hf][s][1], a10 = vf[1][hf][s][0], a11 = vf[1][hf][s][1];
                    const h16x8 va0 = {a00[0], a00[1], a00[2], a00[3], a01[0], a01[1], a01[2], a01[3]};
                    const h16x8 va1 = {a10[0], a10[1], a10[2], a10[3], a11[0], a11[1], a11[2], a11[3]};
                    o0 = __builtin_amdgcn_mfma_f32_32x32x16_f16(va0, pa[hf][s], o0, 0, 0, 0);
                    o1 = __builtin_amdgcn_mfma_f32_32x32x16_f16(va1, pa[hf][s], o1, 0, 0, 0);
                }
            __builtin_amdgcn_s_setprio(0);
        }
    };
    for (int t = t_lo; t < t_hi; t += 2) {
        {
            FA_LOAD(bk0, bk1, bv, t + 2);
            const u64 selw = selw_n;
            if (MODE == 2) selw_n = bmrow[(size_t)q * 64 + imin(t + 1, t_last)];
            compute(t, 0, selw);
            FA_STORE(ak0, ak1, av, BUF);
            __syncthreads();
#if PROBE_PHASE == 16
            __syncthreads();
#endif
        }
        if (t + 1 >= t_hi) break;
        {
            FA_LOAD(ak0, ak1, av, t + 3);
            const u64 selw = selw_n;
            if (MODE == 2) selw_n = bmrow[(size_t)q * 64 + imin(t + 2, t_last)];
            compute(t + 1, BUF, selw);
            FA_STORE(bk0, bk1, bv, 0);
            __syncthreads();
#if PROBE_PHASE == 16
            __syncthreads();
#endif
        }
    }
#undef FA_LOAD
#undef FA_STORE
    const float lt = l_run + __shfl_xor(l_run, 32);
    const float il = 1.f / lt;
    h16* orow = Ow + (size_t)q * opitch + 4 * hi;
#pragma unroll
    for (int g4 = 0; g4 < 4; ++g4) {
        h16x4 a, b;
#pragma unroll
        for (int e = 0; e < 4; ++e) { a[e] = (h16)(o0[4 * g4 + e] * il); b[e] = (h16)(o1[4 * g4 + e] * il); }
        *(h16x4*)(orow + 8 * g4) = a; *(h16x4*)(orow + 32 + 8 * g4) = b;
    }
}

template <int DQK, int MODE>
__device__ __forceinline__ void fa_unit_p(LAS unsigned char* lds, const h16* Qw, int qpitch, const h16* Kb, int kpitch, const h16* Vb, int vpitch,
                                          int t_lo, int t_hi, int wt_lo, int wt_hi, int qpos_w, const LAS float* tab, const u64* bmrow, h16* Ow, int opitch) {
    typedef FaGeo<DQK> GEO;
    constexpr int KCH = GEO::KCH, KP = GEO::KP, KT = GEO::KT, BUF = GEO::BUF, NKS = DQK / 16;
    const int tid = opaque_i((int)threadIdx.x), lane = tid & 63, q = lane & 31, hi = lane >> 5;
    h16x8 qf[NKS];
#pragma unroll
    for (int ks = 0; ks < NKS; ++ks) qf[ks] = *(const h16x8*)(Qw + (size_t)q * qpitch + ks * 16 + hi * 8);
    const int kc0_key = tid / KCH, kc0_part = tid % KCH;
    const int kc1 = tid + 512, kc1_key = kc1 / KCH, kc1_part = kc1 % KCH;
    constexpr bool K2 = (64 * KCH > 512);
    const bool k1_on = K2 && (kc1 < 64 * KCH);
    const int v_key = tid >> 3, v_part = tid & 7;
    const size_t kg0 = (size_t)kc0_key * kpitch + kc0_part * 8, kg1 = (size_t)kc1_key * kpitch + kc1_part * 8, vg = (size_t)v_key * vpitch + v_part * 8;
    const int kl0 = kc0_key * KP + kc0_part * 16, kl1 = kc1_key * KP + kc1_part * 16, vl = KT + (v_part >> 2) * 4096 + v_key * 64 + (v_part & 3) * 16;
    const int ka_off = q * KP + hi * 16;
    const int va_off = KT + (4 * hi + ((lane & 15) >> 2)) * 64 + ((lane >> 4) & 1) * 32 + (lane & 3) * 8;
    f32x16 o0, o1;
#pragma unroll
    for (int r = 0; r < 16; ++r) { o0[r] = 0.f; o1[r] = 0.f; }
    float m_run = 0.f, l_run = 0.f; bool m_init = true;
    u32x4 ak0, ak1, av, bk0, bk1, bv;
    const int t_last = t_hi - 1;
#define FAP_LOAD(K0, K1, V, tt) do { const int tc_ = imin((tt), t_last); const h16* kt_ = Kb + (size_t)tc_ * 64 * kpitch; const h16* vt_ = Vb + (size_t)tc_ * 64 * vpitch; \
        K0 = *(const u32x4*)(kt_ + kg0); if (K2) K1 = *(const u32x4*)(kt_ + (k1_on ? kg1 : kg0)); V = *(const u32x4*)(vt_ + vg); } while (0)
#define FAP_STORE(K0, K1, V, boff) do { *(LAS u32x4*)(lds + (boff) + kl0) = K0; if (K2 && k1_on) *(LAS u32x4*)(lds + (boff) + kl1) = K1; *(LAS u32x4*)(lds + (boff) + vl) = V; } while (0)
#define FAP_INIT(P0, P1, TT, SELW) do { \
        const bool nearb_ = (MODE >= 1) && (((qpos_w >> 6) - (TT)) < 5); \
        if (MODE >= 1 && nearb_) { const LAS float* tj_ = tab + (382 - (qpos_w + q - 64 * (TT) - 4 * hi + 63)); \
            _Pragma("unroll") for (int r = 0; r < 16; ++r) { const int c_ = (r & 3) + 8 * (r >> 2); P0[r] = tj_[c_] - m_run; P1[r] = tj_[c_ + 32] - m_run; } } \
        else { const float ci_ = ((MODE >= 1) ? tab[63] : 0.f) - m_run; _Pragma("unroll") for (int r = 0; r < 16; ++r) { P0[r] = ci_; P1[r] = ci_; } } \
        if (MODE == 2) { const int w0_ = (int)((unsigned)(SELW) >> (4 * hi)), w1_ = (int)((unsigned)((SELW) >> 32) >> (4 * hi)); \
            _Pragma("unroll") for (int r = 0; r < 16; ++r) { const int bp_ = (r & 3) + 8 * (r >> 2); \
                const unsigned m0_ = (unsigned)__builtin_amdgcn_sbfe(w0_, bp_, 1), m1_ = (unsigned)__builtin_amdgcn_sbfe(w1_, bp_, 1); \
                P0[r] = __uint_as_float((__float_as_uint(P0[r]) & m0_) | (0xFF800000u & ~m0_)); P1[r] = __uint_as_float((__float_as_uint(P1[r]) & m1_) | (0xFF800000u & ~m1_)); } } } while (0)
#define FAP_KLOAD(KF, BO) do { _Pragma("unroll") for (int ks = 0; ks < NKS; ++ks) { KF[2 * ks] = *(const LAS h16x8*)(lds + (BO) + ka_off + ks * 32); KF[2 * ks + 1] = *(const LAS h16x8*)(lds + (BO) + ka_off + 32 * KP + ks * 32); } } while (0)
#define FAP_SMFMA(P0, P1, KF) do { _Pragma("unroll") for (int ks = 0; ks < NKS; ++ks) { \
        P0 = __builtin_amdgcn_mfma_f32_32x32x16_f16(KF[2 * ks], qf[ks], P0, 0, 0, 0); P1 = __builtin_amdgcn_mfma_f32_32x32x16_f16(KF[2 * ks + 1], qf[ks], P1, 0, 0, 0); } } while (0)
#define FAP_MAX(MT, P0, P1) do { MT = max3f(P0[0], P0[1], P1[0]); MT = max3f(MT, P1[1], P0[2]); \
        _Pragma("unroll") for (int r = 2; r < 15; ++r) MT = max3f(MT, P1[r], P0[r + 1]); MT = max3f(MT, P1[15], P1[15]); \
        const auto rr_ = __builtin_amdgcn_permlane32_swap(__float_as_uint(MT), __float_as_uint(MT), false, false); MT = max3f(__uint_as_float(rr_[0]), __uint_as_float(rr_[1]), MT); } while (0)
#define FAP_DECIDE(MT, P0, P1) do { const bool upd_ = ((MT) > -INFINITY) && (m_init || (MT) > FA_THR); \
        if (__any(upd_)) { const float d_ = upd_ ? (MT) : 0.f, al_ = __builtin_amdgcn_exp2f(-d_); m_run += d_; l_run *= al_; m_init = m_init && !upd_; \
            _Pragma("unroll") for (int r = 0; r < 16; ++r) { P0[r] -= d_; P1[r] -= d_; o0[r] *= al_; o1[r] *= al_; } } } while (0)
#define FAP_EXP(P0, P1, PA) do { float ps_ = 0.f; \
        _Pragma("unroll") for (int r = 0; r < 16; ++r) { P0[r] = __builtin_amdgcn_exp2f(P0[r]); P1[r] = __builtin_amdgcn_exp2f(P1[r]); ps_ += P0[r] + P1[r]; } l_run += ps_; \
        _Pragma("unroll") for (int s = 0; s < 2; ++s) _Pragma("unroll") for (int e = 0; e < 8; ++e) { PA[0][s][e] = (h16)P0[8 * s + e]; PA[1][s][e] = (h16)P1[8 * s + e]; } } while (0)
#define FAP_PV(PA, BO) do { const LAS unsigned char* vb_ = lds + (BO) + va_off; \
        _Pragma("unroll") for (int hf = 0; hf < 2; ++hf) _Pragma("unroll") for (int s = 0; s < 2; ++s) { const int ko_ = (32 * hf + 16 * s) * 64; \
            const h16x4 a00 = fa_tr(vb_ + ko_), a01 = fa_tr(vb_ + ko_ + 8 * 64), a10 = fa_tr(vb_ + 4096 + ko_), a11 = fa_tr(vb_ + 4096 + ko_ + 8 * 64); \
            const h16x8 va0 = {a00[0], a00[1], a00[2], a00[3], a01[0], a01[1], a01[2], a01[3]}; const h16x8 va1 = {a10[0], a10[1], a10[2], a10[3], a11[0], a11[1], a11[2], a11[3]}; \
            o0 = __builtin_amdgcn_mfma_f32_32x32x16_f16(va0, PA[hf][s], o0, 0, 0, 0); o1 = __builtin_amdgcn_mfma_f32_32x32x16_f16(va1, PA[hf][s], o1, 0, 0, 0); } } while (0)
    FAP_LOAD(ak0, ak1, av, t_lo); FAP_STORE(ak0, ak1, av, 0);
    FAP_LOAD(ak0, ak1, av, t_lo + 1); FAP_STORE(ak0, ak1, av, BUF);
    FAP_LOAD(ak0, ak1, av, t_lo + 2);
    u64 selw_a = 0ull, selw_b = 0ull;
    if (MODE == 2) { selw_a = bmrow[(size_t)q * 64 + t_lo]; selw_b = bmrow[(size_t)q * 64 + imin(t_lo + 1, t_last)]; }
    __syncthreads();
    f32x16 p0, p1;
#pragma unroll
    for (int r = 0; r < 16; ++r) { p0[r] = -INFINITY; p1[r] = -INFINITY; }
    if (t_lo >= wt_lo && t_lo < wt_hi) {
        h16x8 kf[2 * NKS];
        FAP_INIT(p0, p1, t_lo, selw_a); FAP_KLOAD(kf, 0); FAP_SMFMA(p0, p1, kf);
        asm volatile("s_nop 15\n\ts_nop 7" : "+v"(p0), "+v"(p1));
        float mt; FAP_MAX(mt, p0, p1); FAP_DECIDE(mt, p0, p1);
    }
    int bcur = 0, bnxt = BUF, bwr = 2 * BUF;
    for (int t = t_lo; t < t_hi; ++t) {
        const bool odd = ((t - t_lo) & 1) != 0;
        if (!odd) FAP_LOAD(bk0, bk1, bv, t + 3); else FAP_LOAD(ak0, ak1, av, t + 3);
        const u64 selw_n = selw_b;
        if (MODE == 2) selw_b = bmrow[(size_t)q * 64 + imin(t + 2, t_last)];
        const bool in_cur = (t >= wt_lo && t < wt_hi), in_nxt = (t + 1 >= wt_lo && t + 1 < wt_hi && t + 1 < t_hi);
        f32x16 n0, n1;
#pragma unroll
        for (int r = 0; r < 16; ++r) { n0[r] = -INFINITY; n1[r] = -INFINITY; }
        if (in_cur && in_nxt) {
            h16x8 kf[2 * NKS]; h16x8 pa[2][2];
            FAP_INIT(n0, n1, t + 1, selw_n);
            FAP_KLOAD(kf, bnxt);
            __builtin_amdgcn_sched_barrier(0);
            FAP_SMFMA(n0, n1, kf);
            FAP_EXP(p0, p1, pa);
            FAP_PV(pa, bcur);
            asm volatile("s_nop 7" : "+v"(n0), "+v"(n1));
            float mt; FAP_MAX(mt, n0, n1);
            FAP_DECIDE(mt, n0, n1);
        } else if (in_cur) {
            h16x8 pa[2][2];
            FAP_EXP(p0, p1, pa); FAP_PV(pa, bcur);
        } else if (in_nxt) {
            h16x8 kf[2 * NKS];
            FAP_INIT(n0, n1, t + 1, selw_n); FAP_KLOAD(kf, bnxt); FAP_SMFMA(n0, n1, kf);
            asm volatile("s_nop 15\n\ts_nop 7" : "+v"(n0), "+v"(n1));
            float mt; FAP_MAX(mt, n0, n1); FAP_DECIDE(mt, n0, n1);
        }
        p0 = n0; p1 = n1;
        if (!odd) FAP_STORE(ak0, ak1, av, bwr); else FAP_STORE(bk0, bk1, bv, bwr);
        __syncthreads();
        { const int tmp = bcur; bcur = bnxt; bnxt = bwr; bwr = tmp; }
    }
#undef FAP_LOAD
#undef FAP_STORE
#undef FAP_INIT
#undef FAP_KLOAD
#undef FAP_SMFMA
#undef FAP_MAX
#undef FAP_DECIDE
#undef FAP_EXP
#undef FAP_PV
    const float lt = l_run + __shfl_xor(l_run, 32);
    const float il = 1.f / lt;
    h16* orow = Ow + (size_t)q * opitch + 4 * hi;
#pragma unroll
    for (int g4 = 0; g4 < 4; ++g4) {
        h16x4 a, b;
#pragma unroll
        for (int e = 0; e < 4; ++e) { a[e] = (h16)(o0[4 * g4 + e] * il); b[e] = (h16)(o1[4 * g4 + e] * il); }
        *(h16x4*)(orow + 8 * g4) = a; *(h16x4*)(orow + 32 + 8 * g4) = b;
    }
}

__device__ __forceinline__ int wave_total(int c) {
    int t = 0;
#pragma unroll
    for (int b = 0; b < 7; ++b) t += __builtin_popcountll(__ballot((c >> b) & 1)) << b;
    return t;
}
__device__ __forceinline__ unsigned ord_key(float f) { const unsigned b = __float_as_uint(f); return b ^ ((unsigned)((int)b >> 31) | 0x80000000u); }
template <int NJ>
__device__ __forceinline__ u64 select256(const float* sc, LAS unsigned* cand, int nt, int lane) {
    float f[NJ]; float s1 = 0.f, s2 = 0.f;
#pragma unroll
    for (int j = 0; j < NJ; ++j) {
        float v = -INFINITY;
        if (j < NJ - 16 || j < nt) v = sc[j * 64 + lane];
        f[j] = v;
    }
#pragma unroll
    for (int j = 0; j < NJ; ++j) if (j < NJ - 16 || j < nt) { s1 += f[j]; s2 += f[j] * f[j]; }
    constexpr float BIGF = 1152921504606846976.f;
#define SEL_GT(C, PV) do { const float pb_ = -(PV) * BIGF; float a0_ = 0.f, a1_ = 0.f, a2_ = 0.f, a3_ = 0.f; \
        _Pragma("unroll") for (int j = 0; j < NJ; j += 4) { \
            a0_ += __builtin_amdgcn_fmed3f(__builtin_fmaf(f[j], BIGF, pb_), 0.f, 1.f); a1_ += __builtin_amdgcn_fmed3f(__builtin_fmaf(f[j + 1], BIGF, pb_), 0.f, 1.f); \
            a2_ += __builtin_amdgcn_fmed3f(__builtin_fmaf(f[j + 2], BIGF, pb_), 0.f, 1.f); a3_ += __builtin_amdgcn_fmed3f(__builtin_fmaf(f[j + 3], BIGF, pb_), 0.f, 1.f); } \
        C = wave_total((int)((a0_ + a1_) + (a2_ + a3_))); } while (0)
#pragma unroll
    for (int o = 1; o < 8; o <<= 1) { s1 += __shfl_xor(s1, o); s2 += __shfl_xor(s2, o); }
    const float cntf = 8.f * (float)nt;
    const float mu = __int_as_float(__builtin_amdgcn_readfirstlane(__float_as_int(s1 / cntf)));
    const float var = __int_as_float(__builtin_amdgcn_readfirstlane(__float_as_int(s2 / cntf))) - mu * mu;
    const float sg = sqrtf(fmaxf(var, 0.f));
    float zq;
    {
        const float pq = 4.f / (float)nt;
        const float qq = pq < 0.5f ? pq : 1.f - pq;
        const float tt = sqrtf(-2.f * __logf(fmaxf(qq, 1e-6f)));
        const float zz = tt - (2.30753f + 0.27061f * tt) / (1.f + 0.99229f * tt + 0.04481f * tt * tt);
        zq = pq < 0.5f ? zz : -zz;
    }
    float flo = 0.f, fhi = 0.f; int c_lo = nt * 64, c_hi = 0; bool lo_set = false, hi_set = false;
    float step = 0.45f * sg, T = 0.f; int found = 0;
    bool ok = sg > 0.f;
    for (int iter = 0; ok && iter < 18; ++iter) {
        float pv;
        if (!lo_set && !hi_set) pv = mu + zq * sg - step;
        else if (lo_set && !hi_set) { pv = (iter == 1) ? mu + zq * sg + step : flo + step; step *= 2.f; }
        else if (!lo_set && hi_set) { pv = fhi - step; step *= 2.f; }
        else {
            float fr = (iter & 1) ? 0.5f : ((float)c_lo - 255.5f) / (float)(c_lo - c_hi);
            fr = fr < 0.06f ? 0.06f : (fr > 0.94f ? 0.94f : fr);
            pv = flo + (fhi - flo) * fr;
            if (!(pv > flo && pv < fhi)) pv = 0.5f * (flo + fhi);
            if (!(pv > flo && pv < fhi)) { ok = false; break; }
        }
        int c; SEL_GT(c, pv);
        if (c == 255 || c == 256) {
            float m = (c == 255) ? -INFINITY : INFINITY;
            if (c == 255) {
#pragma unroll
                for (int j = 0; j < NJ; ++j) m = fmaxf(m, (f[j] <= pv) ? f[j] : -INFINITY);
#pragma unroll
                for (int o = 1; o < 64; o <<= 1) m = fmaxf(m, __shfl_xor(m, o));
            } else {
#pragma unroll
                for (int j = 0; j < NJ; ++j) m = fminf(m, (f[j] > pv) ? f[j] : INFINITY);
#pragma unroll
                for (int o = 1; o < 64; o <<= 1) m = fminf(m, __shfl_xor(m, o));
            }
            T = m; found = (c == 255) ? 1 : 2; break;
        }
        if (c > 256) { flo = pv; c_lo = c; lo_set = true; } else { fhi = pv; c_hi = c; hi_set = true; }
    }
    u64 myword = 0ull;
    int c_gt = 0, c_ge = 0; unsigned Tu = 0u;
    if (found == 2) { c_ge = 256; c_gt = 0; }
    else if (found == 1) {
        const unsigned tb = __float_as_uint(T);
        const float Tp = (T > 0.f) ? __uint_as_float(tb - 1u) : (T == 0.f ? __uint_as_float(0x80000001u) : __uint_as_float(tb + 1u));
        SEL_GT(c_ge, Tp); c_gt = 255;
    }
#undef SEL_GT
    if (found && c_ge == 256) {
#pragma unroll
        for (int j = 0; j < NJ; ++j) {
            if (j < NJ - 16 || j < nt) { const u64 ge = __ballot(f[j] >= T); if (lane == j) myword = ge; }
            if ((j & 7) == 7) __builtin_amdgcn_sched_barrier(0);
        }
        return myword;
    }
    unsigned u[NJ];
#pragma unroll
    for (int j = 0; j < NJ; ++j) u[j] = (j < NJ - 16 || j < nt) ? ord_key(f[j]) : 0u;
    const u64 lt_mask = (lane == 0) ? 0ull : (~0ull >> (64 - lane));
#define SEL_COUNT(C, CND) do { C = 0; _Pragma("unroll") for (int j = 0; j < NJ; ++j) { C += __builtin_popcountll(__ballot(u[j] >= (CND))); if ((j & 7) == 7) __builtin_amdgcn_sched_barrier(0); } } while (0)
    if (found) { Tu = ord_key(T); }
    else {
        int cl = nt * 64, ch = 0, bit = 31;
        while (bit >= 0 && cl - ch > 64) {
            const unsigned cnd = Tu | (1u << bit); int c; SEL_COUNT(c, cnd);
            if (c >= 256) { Tu = cnd; cl = c; } else { ch = c; }
            --bit;
        }
        if (bit >= 0) {
            const int sh = bit + 1; int base = 0;
#pragma unroll
            for (int j = 0; j < NJ; ++j) {
                const bool inb = (((u[j] ^ Tu) >> sh) == 0u) && (j < NJ - 16 || j < nt);
                const u64 m = __ballot(inb);
                if (m) { if (inb) cand[base + __builtin_popcountll(m & lt_mask)] = u[j]; base += __builtin_popcountll(m); }
            }
            asm volatile("s_waitcnt lgkmcnt(0)" ::: "memory");
            const bool valid = lane < base; const unsigned mine = valid ? cand[lane] : 0u;
            for (; bit >= 0; --bit) {
                const unsigned cnd = Tu | (1u << bit);
                const int c = ch + __builtin_popcountll(__ballot(valid && mine >= cnd));
                if (c >= 256) Tu = cnd;
            }
        }
        { const unsigned T1 = Tu + 1u; SEL_COUNT(c_gt, T1); if (Tu == 0xFFFFFFFFu) c_gt = 0; }
    }
#undef SEL_COUNT
    int need = 256 - c_gt;
#pragma unroll
    for (int j = 0; j < NJ; ++j) {
        if (j < NJ - 16 || j < nt) {
            const u64 gt = __ballot(u[j] > Tu), eq = __ballot(u[j] == Tu);
            u64 w = gt;
            if (eq) {
                const int rank = __builtin_popcountll(eq & lt_mask);
                const u64 tk = __ballot(u[j] == Tu && rank < need);
                need -= __builtin_popcountll(tk); w |= tk;
            }
            if (lane == j) myword = w;
        }
        if ((j & 3) == 3) __builtin_amdgcn_sched_barrier(0);
    }
    return myword;
}

__device__ __forceinline__ void store_tile32(const f32x16& a, LAS unsigned char* stg, h16* gbase, int pitch, int lane) {
    const int tok = lane & 31, hi = lane >> 5;
#pragma unroll
    for (int r4 = 0; r4 < 4; ++r4) {
        h16x4 o;
#pragma unroll
        for (int e = 0; e < 4; ++e) o[e] = (h16)a[4 * r4 + e];
        *(LAS h16x4*)(stg + tok * 80 + (8 * r4 + 4 * hi) * 2) = o;
    }
    asm volatile("s_waitcnt lgkmcnt(0)" ::: "memory");
#pragma unroll
    for (int j = 0; j < 2; ++j) {
        const int tt = (lane >> 2) + 16 * j, pc = lane & 3;
        const u32x4 v = *(const LAS u32x4*)(stg + tt * 80 + pc * 16);
        *(u32x4*)(gbase + (size_t)tt * pitch + pc * 8) = v;
    }
    asm volatile("s_waitcnt lgkmcnt(0)" ::: "memory");
}

constexpr size_t SC_BATCH = 8519680;
__device__ __forceinline__ float* sc_batch(float* dout, unsigned char* ws, int b) { const int i = b & 7; return i < 7 ? dout + (size_t)i * SC_BATCH : (float*)(ws + WS_XG); }


#if PROBE_PHASE == 22
#define IDX_PROBE_MFMA() do { f32x16 d_; _Pragma("unroll") for (int r = 0; r < 16; ++r) d_[r] = 0.f; \
    _Pragma("unroll") for (int i_ = 0; i_ < 4; ++i_) _Pragma("unroll") for (int ks = 0; ks < 4; ++ks) d_ = __builtin_amdgcn_mfma_f32_32x32x16_f16(af[i_ & 1][ks], bf_[i_ >> 1][ks], d_, 0, 0, 0); \
    asm volatile("" :: "v"(d_)); } while (0)
#else
#define IDX_PROBE_MFMA() do { } while (0)
#endif
#if PROBE_PHASE == 23
#define IDX_PROBE_STORE() do { float* dz_ = (float*)(ws + (size_t)984 * MiB) + (((size_t)(bx * 8 + wave) * 4096 + (mb * 4 + nb * 2 + a) * 64 + lane) & ((size_t)8 * 1024 * 1024 - 1)); *dz_ = s_; } while (0)
#else
#define IDX_PROBE_STORE() do { } while (0)
#endif

#if PROBE_PHASE == 24
#define IDX_PROBE_VALU() do { float s2_ = 0.f; _Pragma("unroll") for (int e = 0; e < 8; ++e) s2_ += wq[mb][8 * a + e] * __builtin_amdgcn_fmed3f(c_[mb][nb][8 * a + e] + 1.f, 0.f, __builtin_inff()); asm volatile("" :: "v"(s2_)); } while (0)
#else
#define IDX_PROBE_VALU() do { } while (0)
#endif
#define LDS_BARRIER() asm volatile("s_waitcnt lgkmcnt(0)\n\ts_barrier" ::: "memory")
#define IDX_SCORE_ROUND(RND) do { PHASE_ENV(layer) \
    const h16* IKB = (const h16*)(ws + WS_IKB); \
    const int q31 = lane & 31, hi = lane >> 5; \
    constexpr int IKP = 144, ITB = 64 * IKP, ISTG = 2 * ITB;        \
    const int skey = tid >> 3, spart = tid & 7; const int sl = skey * IKP + spart * 16; \
    const int vcu_ = (G % 8 == 0) ? (bx % 8) * (G / 8) + bx / 8 : bx;        \
    for (int it = vcu_; it < 8 * 32; it += G) { \
        _Pragma("unroll 1") for (int side = 0; side < 2; ++side) { \
            const int b = (RND) * 8 + (it >> 5), cp = it & 31, c = side ? 63 - cp : cp; \
            if (c < 4) continue; \
            const size_t brow = (size_t)b * SEQ; const int t0 = c * 64 + wave * 8; \
            float* scw = sc_batch(P.out, ws, b) + (size_t)2048 * c * (c + 1) + (size_t)(wave * 8) * 64 * (c + 1); \
            h16x8 af[2][4]; float wq[2][16]; \
            { const int ql = 2 * ((q31 >> 2) & 1) + (q31 >> 4), hd = 4 * ((q31 >> 3) & 1) + (q31 & 3); \
              _Pragma("unroll") for (int mb = 0; mb < 2; ++mb) { \
                const h16* zq = Zb + (brow + t0 + 4 * mb + ql) * ZW + ZC_IDXQ + hd * 64 + hi * 8; \
                _Pragma("unroll") for (int ks = 0; ks < 4; ++ks) af[mb][ks] = *(const h16x8*)(zq + ks * 16); \
                _Pragma("unroll") for (int a = 0; a < 2; ++a) { const h16x8 w8 = *(const h16x8*)(Zb + (brow + t0 + 4 * mb + 2 * hi + a) * ZW + ZC_IDXW); \
                    _Pragma("unroll") for (int e = 0; e < 8; ++e) wq[mb][8 * a + e] = (float)w8[e]; } } } \
            const h16* kg = IKB + (brow + skey) * 64 + spart * 8; \
            const int rowp_ = 64 * (c + 1); const unsigned lane_off_ = (unsigned)(2 * hi * rowp_ + q31); \
            const int np = (c + 2) >> 1;                         \
            u32x4 ra0, ra1, rb0, rb1; \
            ra0 = *(const u32x4*)kg; ra1 = *(const u32x4*)(kg + (size_t)imin(1, c) * 4096); \
            *(LAS u32x4*)(lds + sl) = ra0; *(LAS u32x4*)(lds + ITB + sl) = ra1; \
            ra0 = *(const u32x4*)(kg + (size_t)imin(2, c) * 4096); ra1 = *(const u32x4*)(kg + (size_t)imin(3, c) * 4096); \
            LDS_BARRIER(); \
            for (int p = 0; p < np; p += 2) { \
                rb0 = *(const u32x4*)(kg + (size_t)imin(2 * p + 4, c) * 4096); rb1 = *(const u32x4*)(kg + (size_t)imin(2 * p + 5, c) * 4096); \
                IDX_SCORE_TILE(2 * p, 0); \
                if (2 * p + 1 <= c) IDX_SCORE_TILE(2 * p + 1, ITB); \
                *(LAS u32x4*)(lds + ISTG + sl) = ra0; *(LAS u32x4*)(lds + ISTG + ITB + sl) = ra1; \
                LDS_BARRIER(); \
                if (p + 1 >= np) break; \
                ra0 = *(const u32x4*)(kg + (size_t)imin(2 * p + 6, c) * 4096); ra1 = *(const u32x4*)(kg + (size_t)imin(2 * p + 7, c) * 4096); \
                IDX_SCORE_TILE(2 * p + 2, ISTG); \
                if (2 * p + 3 <= c) IDX_SCORE_TILE(2 * p + 3, ISTG + ITB); \
                *(LAS u32x4*)(lds + sl) = rb0; *(LAS u32x4*)(lds + ITB + sl) = rb1; \
                LDS_BARRIER(); \
            } \
        } \
    } } while (0)
#define IDX_SCORE_TILE(TT, BOFF) do { \
    h16x8 bf_[2][4]; \
    _Pragma("unroll") for (int nb = 0; nb < 2; ++nb) _Pragma("unroll") for (int ks = 0; ks < 4; ++ks) bf_[nb][ks] = *(const LAS h16x8*)(lds + (BOFF) + (nb * 32 + q31) * IKP + ks * 32 + hi * 16); \
    f32x16 c_[2][2]; \
    _Pragma("unroll") for (int mb = 0; mb < 2; ++mb) _Pragma("unroll") for (int nb = 0; nb < 2; ++nb) { \
        f32x16 z_; _Pragma("unroll") for (int r = 0; r < 16; ++r) z_[r] = 0.f; \
        _Pragma("unroll") for (int ks = 0; ks < 4; ++ks) z_ = __builtin_amdgcn_mfma_f32_32x32x16_f16(af[mb][ks], bf_[nb][ks], z_, 0, 0, 0); \
        c_[mb][nb] = z_; } \
    IDX_PROBE_MFMA(); \
    __builtin_amdgcn_sched_barrier(0); \
    _Pragma("unroll") for (int mb = 0; mb < 2; ++mb) _Pragma("unroll") for (int nb = 0; nb < 2; ++nb) _Pragma("unroll") for (int a = 0; a < 2; ++a) { \
        f32x2 s2_ = {0.f, 0.f}; \
        _Pragma("unroll") for (int e = 0; e < 8; e += 2) { f32x2 r2_; r2_[0] = __int_as_float(imax(__float_as_int(c_[mb][nb][8 * a + e]), 0)); r2_[1] = __int_as_float(imax(__float_as_int(c_[mb][nb][8 * a + e + 1]), 0));        \
            s2_ += (f32x2){wq[mb][8 * a + e], wq[mb][8 * a + e + 1]} * r2_; } \
        const float s_ = s2_[0] + s2_[1];                   \
        IDX_PROBE_VALU(); __builtin_nontemporal_store(s_, scw + (unsigned)((4 * mb + a) * rowp_ + (TT) * 64 + nb * 32) + lane_off_); IDX_PROBE_STORE(); } } while (0)

#define IDX_SELECT_ROUND(RND) do { PHASE_ENV(layer) \
    LAS unsigned* cand = (LAS unsigned*)lds + wave * 64; \
    for (int it = gw; it < 8 * 32 * 64; it += ngw) { \
        _Pragma("unroll 1") for (int side = 0; side < 2; ++side) { \
            const int b = (RND) * 8 + (it >> 11), cp = (it >> 6) & 31, ql = it & 63, c = side ? 63 - cp : cp, nt = c + 1; \
            const size_t row = (size_t)b * SEQ + c * 64 + ql; \
            u64 myword; \
            if (nt <= 4) myword = (lane < nt) ? ~0ull : 0ull; \
            else { const float* sc = sc_batch(P.out, ws, b) + (size_t)2048 * c * (c + 1) + (size_t)ql * 64 * (c + 1); \
                if (nt <= 16) myword = select256<16>(sc, cand, nt, lane); \
                else if (nt <= 32) myword = select256<32>(sc, cand, nt, lane); \
                else if (nt <= 48) myword = select256<48>(sc, cand, nt, lane); \
                else myword = select256<64>(sc, cand, nt, lane); } \
            BM[row * 64 + lane] = myword; \
        } \
    } } while (0)

#ifndef FA_PIPE
#define FA_PIPE 0
#endif
#if FA_PIPE
#define FA_UNIT fa_unit_p
#else
#define FA_UNIT fa_unit
#endif
#ifndef PROBE_PHASE
#define PROBE_PHASE -1
#endif
#define REPW(k) for (int repw_ = 0; repw_ < ((PROBE_PHASE == (k)) ? 2 : 1); ++repw_)
#define REP(k) for (int rep_ = 0; rep_ < ((PROBE_PHASE == (k)) ? 2 : 1); ++rep_, __syncthreads())
#ifndef NAIVE_GEMM
#define NAIVE_GEMM 0
#endif
#ifndef NAIVE_MLA
#define NAIVE_MLA 0
#endif
#ifndef NAIVE_TL
#define NAIVE_TL 0
#endif
#ifndef NAIVE_IDX
#define NAIVE_IDX 0
#endif
#ifndef NAIVE_BAND
#define NAIVE_BAND 0
#endif
#ifndef NAIVE_DSA_ATTN
#define NAIVE_DSA_ATTN 0
#endif
#if NAIVE_GEMM
#define RUN_GEMM(EPI, E, A_, Bt_, N_, K_) naive_gemm(lds, A_, Bt_, MROWS, N_, K_, E)
#else
#define RUN_GEMM(EPI, E, A_, Bt_, N_, K_) do { pg8::Gemm g_{A_, Bt_, MROWS, N_, K_}; pg8::StaticOrder S_; S_.init(MROWS, N_, G, bx); pg8::EpiWrap<EPI> W_{E}; \
    pg8::gemm_phase<pg8::EpiWrap<EPI>, pg8::StaticOrder, true, true>(lds, g_, S_, W_); } while (0)
#endif

constexpr int PH_PER_LAYER = 10, PH_L0 = 2, NPHASE = PH_L0 + PH_PER_LAYER * NLAYER + 1;
__global__ void __launch_bounds__(NTHR, 2) fwd(Args args) {
    extern __shared__ __attribute__((aligned(16))) unsigned char lds_raw[];
    LAS unsigned char* lds = (LAS unsigned char*)lds_raw;
    const Ptrs& P = args.p;
    const int tid = threadIdx.x;
    unsigned char* const ws0 = P.ws;
    volatile LAS unsigned* MISC = (volatile LAS unsigned*)(lds + MISC_OFF);
    for (int u = tid; u < (LDS_BYTES - MISC_OFF) / 4; u += NTHR) MISC[u] = 0u;
    __syncthreads();
    XcdBarrier bar; bar.bar = (unsigned*)(ws0 + WS_CTL) + CW_BAR; bar.x = 0; bar.st = nullptr;
    if (args.use_bar) bar = xcd_barrier_post((unsigned*)(ws0 + WS_CTL) + CW_BAR, MISC + 8);
    const int lo = args.ph_lo, hi = args.ph_hi;
#define IN(k) (lo <= (k) && (k) < hi)
#if PROBE_PHASE == 18
#define SEAM(k) do { if (IN(k) && IN((k) + 1)) { xcd_barrier(bar); xcd_barrier(bar); } } while (0)
#else
#define SEAM(k) do { if (IN(k) && IN((k) + 1)) xcd_barrier(bar); } while (0)
#endif

    if (IN(0)) { PHASE_ENV(0)
        LAS float* scr = (LAS float*)(lds + wave * 16384);
        constexpr int I_IN = 80 * 16, I_OUT = 32 * 16, I_UP = 176 * 16, I_DN = 32 * 44, I_L = I_IN + I_OUT + I_UP + I_DN;
        for (int it = gw; it < NLAYER * I_L; it += ngw) {
            const int l = it / I_L; int r = it % I_L;
            unsigned char* wl = ws + WS_W + (size_t)l * W_LAYER;
            if (r < I_IN) {
                const float* W = P.w_in + (size_t)l * DM * INW;
                const int nb = r / 16, kb = r % 16;
                cvt_item((h16*)(wl + WO_IN), DM, nb * 32, kb * 64, scr, lane, [&](int n, int k) -> float {
                    const int sc = zsrc_col(n); if (sc < 0) return 0.f;
                    const float v = W[(size_t)k * INW + sc];
                    return ((n >= ZC_CAQ && n < ZC_CAK) || (n >= ZC_SAQ && n < ZC_IDXQ)) ? v * (0.125f * LOG2E) : v; });
                continue;
            }
            r -= I_IN;
            if (r < I_OUT) {
                const float* W = P.w_out + (size_t)l * DM * DM;
                const int nb = r / 16, kb = r % 16;
                cvt_item((h16*)(wl + WO_OUT), DM, nb * 32, kb * 64, scr, lane, [&](int n, int k) -> float { return W[(size_t)k * DM + n]; });
                continue;
            }
            r -= I_OUT;
            if (r < I_UP) {
                const float* W1 = P.w1 + (size_t)l * DM * FF; const float* W3 = P.w3 + (size_t)l * DM * FF;
                const int nb = r / 16, kb = r % 16;
                cvt_item((h16*)(wl + WO_UP), DM, nb * 32, kb * 64, scr, lane, [&](int n, int k) -> float { return (n & 1) ? W3[(size_t)k * FF + (n >> 1)] : W1[(size_t)k * FF + (n >> 1)]; });
                continue;
            }
            r -= I_UP;
            {
                const float* W = P.w2 + (size_t)l * FF * DM;
                const int nb = r / 44, kb = r % 44;
                cvt_item((h16*)(wl + WO_DN), FF, nb * 32, kb * 64, scr, lane, [&](int n, int k) -> float { return W[(size_t)k * DM + n]; });
            }
        }
        {
            constexpr int J_UQ = 12 * 4, J_UKV = 16 * 2, J_PW = 8, J_L = J_UQ + J_UKV + J_PW;
            for (int it = gw; it < NLAYER * J_L; it += ngw) {
                const int l2 = it / J_L; int r = it % J_L;
                unsigned char* tl = ws + WS_TLW + (size_t)l2 * TLW_LAYER;
                if (r < J_UQ) {
                    const float* W = P.w_uq + (size_t)l2 * 256 * 384; const float* gq = P.g_cq + (size_t)l2 * 256;
                    cvt_item((h16*)(tl + TO_UQ), 256, (r / 4) * 32, (r % 4) * 64, scr, lane, [&](int n, int k) -> float { return W[(size_t)k * 384 + n] * gq[k]; });
                    continue;
                }
                r -= J_UQ;
                if (r < J_UKV) {
                    const float* W = P.w_ukv + (size_t)l2 * 128 * 512; const float* gk = P.g_ckv + (size_t)l2 * 128;
                    cvt_item((h16*)(tl + TO_UKV), 128, (r / 2) * 32, (r % 2) * 64, scr, lane, [&](int n, int k) -> float { return W[(size_t)k * 512 + n] * gk[k]; });
                    continue;
                }
                r -= J_UKV;
                {
                    const float* W = P.pool_w + (size_t)l2 * 4 * 64 * 64; const float* psc = P.pool_scale + (size_t)l2 * 256;
                    cvt_item((h16*)(tl + TO_POOL), 64, r * 32, 0, scr, lane, [&](int n, int k) -> float { return W[((size_t)(n >> 6) * 64 + k) * 64 + (n & 63)] * psc[n]; });
                }
            }
        }
        __syncthreads();
        for (int it = bx; it < NLAYER * 96; it += G) {
            const int l = it / 96, jb = it % 96;
            LAS float* sc = (LAS float*)lds + wave * 2048;
            LAS float* red = (LAS float*)lds + 8 * 2048;
            for (int i = lane; i < 2048; i += 64) { const int b = i >> 7, kk2 = i & 127; sc[i] = silu_f(P.c[b * DM + wave * 128 + kk2]); }
            asm volatile("s_waitcnt lgkmcnt(0)" ::: "memory");
            float acc[16];
#pragma unroll
            for (int b = 0; b < 16; ++b) acc[b] = 0.f;
            const float* W = P.w_mod + (size_t)l * DM * 6144 + (size_t)(wave * 128) * 6144 + jb * 64 + lane;
#pragma unroll 4
            for (int k = 0; k < 128; ++k) {
                const float w = W[(size_t)k * 6144];
#pragma unroll
                for (int b = 0; b < 16; ++b) acc[b] += sc[b * 128 + k] * w;
            }
#pragma unroll
            for (int b = 0; b < 16; ++b) red[(wave * 16 + b) * 64 + lane] = acc[b];
            __syncthreads();
            for (int o = tid; o < 1024; o += NTHR) {
                const int b = o >> 6, j = o & 63; float s = 0.f;
#pragma unroll
                for (int w = 0; w < 8; ++w) s += red[(w * 16 + b) * 64 + j];
                MOD[((size_t)l * 16 + b) * 6144 + jb * 64 + j] = s + P.b_mod[(size_t)l * 6144 + jb * 64 + j];
            }
            __syncthreads();
        }
        for (int e = bx * NTHR + tid; e < SEQ * 16; e += G * NTHR) {
            const int t = e >> 4, i = e & 15;
            const double fr = exp(-(double)i * (9.210340371976184 / 16.0));
            const double ang = (double)t * fr;
            ROPE[2 * e] = (float)cos(ang); ROPE[2 * e + 1] = (float)sin(ang);
        }
    }
    SEAM(0);

    if (IN(1)) { PHASE_ENV(0)
        float* GMOD = (float*)(ws + WS_GMOD); float* SHW = (float*)(ws + WS_SHW); float* SSQ = (float*)(ws + WS_SSQ); h16* XG = (h16*)(ws + WS_XG);
        for (int e = bx * NTHR + tid; e < NLAYER * 2 * 16 * 1024; e += G * NTHR) {
            const int d = e & 1023, b = (e >> 10) & 15, w = (e >> 14) & 1, l2 = e >> 15;
            const float g = w ? P.g_ffn[(size_t)l2 * DM + d] : P.g_mix[(size_t)l2 * DM + d];
            GMOD[e] = g * (1.f + MOD[((size_t)l2 * 16 + b) * 6144 + (w ? 4 : 1) * 1024 + d]);
        }
        for (int it = bx; it < NLAYER * 128; it += G) {
            const int l2 = it >> 7, cb = it & 127;
            LAS float* sc = (LAS float*)lds + wave * 2048;
            LAS float* red = (LAS float*)lds + 8 * 2048;
            const bool isin = cb < 40;
            for (int i = lane; i < 2048; i += 64) { const int b = i >> 7, kk2 = i & 127; sc[i] = MOD[((size_t)l2 * 16 + b) * 6144 + (isin ? 0 : 3) * 1024 + wave * 128 + kk2]; }
            asm volatile("s_waitcnt lgkmcnt(0)" ::: "memory");
            float acc[16];
#pragma unroll
            for (int b = 0; b < 16; ++b) acc[b] = 0.f;
            const float* W; size_t wstride; float wscale = 1.f; bool valid = true;
            if (isin) {
                const int n = cb * 64 + lane, sc0 = zsrc_col(n);
                valid = sc0 >= 0; W = P.w_in + (size_t)l2 * DM * INW + (valid ? sc0 : 0); wstride = INW;
                if ((n >= ZC_CAQ && n < ZC_CAK) || (n >= ZC_SAQ && n < ZC_IDXQ)) wscale = 0.125f * LOG2E;
            } else {
                const int n = (cb - 40) * 64 + lane;
                W = ((n & 1) ? P.w3 : P.w1) + (size_t)l2 * DM * FF + (n >> 1); wstride = FF;
            }
            W += (size_t)(wave * 128) * wstride;
#pragma unroll 4
            for (int k = 0; k < 128; ++k) {
                const float w = valid ? W[(size_t)k * wstride] * wscale : 0.f;
#pragma unroll
                for (int b = 0; b < 16; ++b) acc[b] += sc[b * 128 + k] * w;
            }
#pragma unroll
            for (int b = 0; b < 16; ++b) red[(wave * 16 + b) * 64 + lane] = acc[b];
            __syncthreads();
            for (int o = tid; o < 1024; o += NTHR) {
                const int b = o >> 6, j = o & 63; float s = 0.f;
#pragma unroll
                for (int w = 0; w < 8; ++w) s += red[(w * 16 + b) * 64 + j];
                SHW[((size_t)l2 * 16 + b) * 8192 + (isin ? cb * 64 : 2560 + (cb - 40) * 64) + j] = s;
            }
            __syncthreads();
        }
        for (int rp = gw; rp < MROWS / 2; rp += ngw) {
            const int row0 = 2 * rp, b = row0 >> 12;
            f32x4 v[2][4]; float s[2] = {0.f, 0.f};
#pragma unroll
            for (int r = 0; r < 2; ++r) { const f32x4* xr = (const f32x4*)(P.x + (size_t)(row0 + r) * DM) + lane;
#pragma unroll
                for (int j = 0; j < 4; ++j) v[r][j] = xr[64 * j]; }
#pragma unroll
            for (int r = 0; r < 2; ++r)
#pragma unroll
                for (int j = 0; j < 4; ++j) s[r] += (v[r][j].x * v[r][j].x + v[r][j].y * v[r][j].y) + (v[r][j].z * v[r][j].z + v[r][j].w * v[r][j].w);
            const float t0 = wave_sum(s[0]), t1 = wave_sum(s[1]);
            if (lane == 0) { SSQ[row0] = t0; SSQ[row0 + 1] = t1; }
#pragma unroll
            for (int j = 0; j < 4; ++j) {
                const int c0 = 4 * lane + 256 * j;
                const f32x4 g = *(const f32x4*)(P.g_mix + c0), sc1 = *(const f32x4*)(MOD + (size_t)b * 6144 + 1024 + c0);
                h16x4 o0, o1;
#pragma unroll
                for (int e = 0; e < 4; ++e) { const float m = g[e] * (1.f + sc1[e]); o0[e] = (h16)(v[0][j][e] * m); o1[e] = (h16)(v[1][j][e] * m); }
                *(h16x4*)(XG + (size_t)row0 * DM + c0) = o0; *(h16x4*)(XG + (size_t)(row0 + 1) * DM + c0) = o1;
            }
        }
    }
    SEAM(1);

#pragma unroll 1
    for (int layer = 0; layer < NLAYER; ++layer) {
        const int pb = PH_L0 + PH_PER_LAYER * layer;

        if (IN(pb + 0)) REP(1) { PHASE_ENV(layer) EpiZn E{Zb, ZW, (h16*)(ws + WS_IKB), (const float*)(ws + WS_SSQ) + (size_t)(2 * l) * MROWS, (const float*)(ws + WS_SHW) + (size_t)l * 16 * 8192};
            pg8::Gemm g_{(const h16*)(ws + WS_XG), (const h16*)(wl + WO_IN), MROWS, ZW, DM}; pg8::StaticOrder S_; S_.init(MROWS, ZW, G, bx);
            pg8::gemm_phase<EpiZn, pg8::StaticOrder, true, true>(lds, g_, S_, E); }
        SEAM(pb + 0);

        if (IN(pb + 1)) {
#if NAIVE_TL
            REP(2) { PHASE_ENV(layer)
                LAS float* dsh = (LAS float*)lds + wave * 256;
                const float* pw = P.pool_w + (size_t)l * 4 * 64 * 64;
                const int g = lane >> 4, win = 2 << g, c0 = 4 * lane;
                for (int row = gw; row < MROWS; row += ngw) {
                    const int t = row & (SEQ - 1);
                    const int cnt = imin(t + 1, win);
                    float s0 = 0.f, s1 = 0.f, s2 = 0.f, s3 = 0.f, u0 = 0.f, u1 = 0.f, u2 = 0.f, u3 = 0.f;
                    for (int j = 0; j < cnt; ++j) {
                        const h16x4 u = *(const h16x4*)(Zb + (size_t)(row - j) * ZW + ZC_POOL + c0);
                        if (j == 0) { u0 = (float)u[0]; u1 = (float)u[1]; u2 = (float)u[2]; u3 = (float)u[3]; }
                        s0 += (float)u[0]; s1 += (float)u[1]; s2 += (float)u[2]; s3 += (float)u[3];
                    }
                    const float ic = 1.f / (float)cnt;
                    *(LAS f32x4*)(dsh + c0) = (f32x4){s0 * ic - u0, s1 * ic - u1, s2 * ic - u2, s3 * ic - u3};
                    asm volatile("s_waitcnt lgkmcnt(0)" ::: "memory");
                    const int d0 = 4 * (lane & 15);
                    f32x4 y = {0.f, 0.f, 0.f, 0.f};
                    const float* pwg = pw + (size_t)g * 4096 + d0;
#pragma unroll 8
                    for (int c = 0; c < 64; ++c) { const float dv = dsh[g * 64 + c]; const f32x4 w = *(const f32x4*)(pwg + c * 64); y += dv * w; }
                    const f32x4 ps = *(const f32x4*)(P.pool_scale + (size_t)l * 256 + c0);
                    y = y * ps;
                    const float ss = wave_sum((y.x * y.x + y.y * y.y) + (y.z * y.z + y.w * y.w));
                    const float rstd = rsqrtf(ss * (1.f / 256.f) + EPSN);
                    const f32x4 gg = *(const f32x4*)(P.g_group + (size_t)l * DM + c0);
                    h16x4 o;
#pragma unroll
                    for (int e = 0; e < 4; ++e) o[e] = (h16)(y[e] * rstd * gg[e]);
                    *(h16x4*)(HY + (size_t)row * DM + c0) = o;
                    asm volatile("s_waitcnt lgkmcnt(0)" ::: "memory");
                }
            }
            __syncthreads();
            REP(3) { PHASE_ENV(layer)
                LAS float* cn = (LAS float*)lds + wave * 4096;
                const float* wuq = P.w_uq + (size_t)l * 256 * 384;
                const float* wukv = P.w_ukv + (size_t)l * 128 * 512;
                const float* gcq = P.g_cq + (size_t)l * 256; const float* gckv = P.g_ckv + (size_t)l * 128;
                const float qscale = 0.10206207261596577f * LOG2E;
                for (int it = gw; it < MROWS / 8; it += ngw) {
                    const int row0 = it * 8;
#pragma unroll 1
                    for (int r = 0; r < 8; ++r) {
                        const h16x4 u = *(const h16x4*)(Zb + (size_t)(row0 + r) * ZW + ZC_CQ + 4 * lane);
                        const float a0 = (float)u[0], a1 = (float)u[1], a2 = (float)u[2], a3 = (float)u[3];
                        const float rstd = rsqrtf(wave_sum((a0 * a0 + a1 * a1) + (a2 * a2 + a3 * a3)) * (1.f / 256.f) + EPSN);
                        const f32x4 gq = *(const f32x4*)(gcq + 4 * lane);
                        *(LAS f32x4*)(cn + r * 256 + 4 * lane) = (f32x4){a0 * rstd * gq.x, a1 * rstd * gq.y, a2 * rstd * gq.z, a3 * rstd * gq.w};
                    }
                    asm volatile("s_waitcnt lgkmcnt(0)" ::: "memory");
                    float acc[6][8];
#pragma unroll
                    for (int j = 0; j < 6; ++j)
#pragma unroll
                        for (int r = 0; r < 8; ++r) acc[j][r] = 0.f;
                    for (int k = 0; k < 256; ++k) {
                        float w[6];
#pragma unroll
                        for (int j = 0; j < 6; ++j) w[j] = wuq[(size_t)k * 384 + lane + 64 * j];
#pragma unroll
                        for (int r = 0; r < 8; ++r) { const float a = cn[r * 256 + k];
#pragma unroll
                            for (int j = 0; j < 6; ++j) acc[j][r] += a * w[j]; }
                    }
                    asm volatile("s_waitcnt lgkmcnt(0)" ::: "memory");
#pragma unroll
                    for (int j = 0; j < 6; ++j)
#pragma unroll
                        for (int r = 0; r < 8; ++r) cn[r * 384 + lane + 64 * j] = acc[j][r];
                    asm volatile("s_waitcnt lgkmcnt(0)" ::: "memory");
#pragma unroll 1
                    for (int r = 0; r < 8; ++r) {
                        const int t = (row0 + r) & (SEQ - 1);
#pragma unroll
                        for (int j = 0; j < 6; ++j) {
                            const int n = lane + 64 * j, hh = n / 96, dd = n % 96;
                            float v = cn[r * 384 + n];
                            if (dd >= 64) { const int i = (dd - 64) & 15; const float cs = ROPE[(t * 16 + i) * 2], sn = ROPE[(t * 16 + i) * 2 + 1];
                                const float x1 = cn[r * 384 + hh * 96 + 64 + i], x2 = cn[r * 384 + hh * 96 + 80 + i];
                                v = (dd < 80) ? (x1 * cs - x2 * sn) : (x1 * sn + x2 * cs); }
                            MQ[(size_t)(row0 + r) * MQW + n] = (h16)(v * qscale);
                        }
                    }
                    asm volatile("s_waitcnt lgkmcnt(0)" ::: "memory");
#pragma unroll 1
                    for (int r = 0; r < 8; ++r) {
                        const h16x2 u = *(const h16x2*)(Zb + (size_t)(row0 + r) * ZW + ZC_CKV + 2 * lane);
                        const float a0 = (float)u[0], a1 = (float)u[1];
                        const float rstd = rsqrtf(wave_sum(a0 * a0 + a1 * a1) * (1.f / 128.f) + EPSN);
                        cn[r * 128 + 2 * lane] = a0 * rstd * gckv[2 * lane]; cn[r * 128 + 2 * lane + 1] = a1 * rstd * gckv[2 * lane + 1];
                    }
                    asm volatile("s_waitcnt lgkmcnt(0)" ::: "memory");
                    float ak[8][8];
#pragma unroll
                    for (int j = 0; j < 8; ++j)
#pragma unroll
                        for (int r = 0; r < 8; ++r) ak[j][r] = 0.f;
                    for (int k = 0; k < 128; ++k) {
                        float w[8];
#pragma unroll
                        for (int j = 0; j < 8; ++j) w[j] = wukv[(size_t)k * 512 + lane + 64 * j];
#pragma unroll
                        for (int r = 0; r < 8; ++r) { const float a = cn[r * 128 + k];
#pragma unroll
                            for (int j = 0; j < 8; ++j) ak[j][r] += a * w[j]; }
                    }
#pragma unroll
                    for (int j = 0; j < 8; ++j)
#pragma unroll
                        for (int r = 0; r < 8; ++r) {
                            if (j & 1) MV[(size_t)(row0 + r) * MVW + (j >> 1) * 64 + lane] = (h16)ak[j][r];
                            else MK[(size_t)(row0 + r) * MKW + (j >> 1) * 96 + lane] = (h16)ak[j][r];
                        }
#pragma unroll
                    for (int e = 0; e < 4; ++e) {
                        const int idx = lane * 4 + e, r = idx >> 5, dd = idx & 31, i = dd & 15;
                        const int t = (row0 + r) & (SEQ - 1);
                        const h16* krp = Zb + (size_t)(row0 + r) * ZW + ZC_KR;
                        const float x1 = (float)krp[i], x2 = (float)krp[16 + i];
                        const float cs = ROPE[(t * 16 + i) * 2], sn = ROPE[(t * 16 + i) * 2 + 1];
                        const h16 v = (h16)((dd < 16) ? (x1 * cs - x2 * sn) : (x1 * sn + x2 * cs));
#pragma unroll
                        for (int hh = 0; hh < 4; ++hh) MK[(size_t)(row0 + r) * MKW + hh * 96 + 64 + dd] = v;
                    }
                    asm volatile("s_waitcnt lgkmcnt(0)" ::: "memory");
                }
            }
            __syncthreads();
#else
            REP(2) { PHASE_ENV(layer)
                const unsigned char* tlw = ws + WS_TLW + (size_t)l * TLW_LAYER;
                const h16* WUQ = (const h16*)(tlw + TO_UQ); const h16* WUKV = (const h16*)(tlw + TO_UKV); const h16* WPL = (const h16*)(tlw + TO_POOL);
                constexpr int WB_BYTES = 32 * 528, PW_OFF = 2 * WB_BYTES, PW_PITCH = 144;
                const int tid_outer = tid;
                for (int it0 = bx * NWAVE; it0 < MROWS / 32; it0 += G * NWAVE) {
                    const int tid = opaque_i(tid_outer), lane = tid & 63, tok = lane & 31, hi = lane >> 5;
                    const int it = it0 + wave;
                    const int row0 = it * 32, row = row0 + tok, t = row & (SEQ - 1);
                    const h16* zr = Zb + (size_t)row * ZW;
                    LAS unsigned char* stg = lds + 73728 + wave * 2560;
                    u32x4 w0, w1;
                    {
                        const int tq = opaque_i(tid);
                        u32x4 pw4[4];
#pragma unroll
                        for (int i = 0; i < 4; ++i) { const int c = tq + 512 * i, r = c >> 3, pt = c & 7; pw4[i] = *(const u32x4*)(WPL + (size_t)r * 64 + pt * 8); }
                        { const int c0 = tq, c1 = tq + 512; w0 = *(const u32x4*)(WUQ + (size_t)(c0 >> 5) * 256 + (c0 & 31) * 8); w1 = *(const u32x4*)(WUQ + (size_t)(c1 >> 5) * 256 + (c1 & 31) * 8); }
#pragma unroll
                        for (int i = 0; i < 4; ++i) { const int c = tq + 512 * i, r = c >> 3, pt = c & 7; *(LAS u32x4*)(lds + PW_OFF + r * PW_PITCH + pt * 16) = pw4[i]; }
                    }
                    __syncthreads();
                    REPW(13)
                    {
                        h16x8 dfr[4][4];
#pragma unroll
                        for (int g = 0; g < 4; ++g) {
                            const int win = 2 << g;
                            const float ic = 1.f / (float)imin(t + 1, win);
#pragma unroll
                            for (int ks = 0; ks < 4; ++ks) {
                                const h16* up = zr + ZC_POOL + g * 64 + ks * 16 + hi * 8;
                                const h16x8 u0 = *(const h16x8*)up;
                                float sm[8];
#pragma unroll
                                for (int e = 0; e < 8; ++e) sm[e] = (float)u0[e];
#pragma unroll
                                for (int jb = 1; jb < win; jb += 8) {
                                    h16x8 uj[8];
#pragma unroll
                                    for (int jj = 0; jj < 8; ++jj) if (jb + jj < win) uj[jj] = *(const h16x8*)(up - (size_t)imin(jb + jj, t) * ZW);
#pragma unroll
                                    for (int jj = 0; jj < 8; ++jj) if (jb + jj < win) {
                                        const float wj = (jb + jj <= t) ? 1.f : 0.f;
#pragma unroll
                                        for (int e = 0; e < 8; ++e) sm[e] += wj * (float)uj[jj][e];
                                    }
                                }
#pragma unroll
                                for (int e = 0; e < 8; ++e) dfr[g][ks][e] = (h16)(sm[e] * ic - (float)u0[e]);
                                asm volatile("" ::: "memory"); __builtin_amdgcn_sched_barrier(0);
                            }
                        }
                        float ss = 0.f;
#pragma unroll 1
                        for (int gm = 0; gm < 8; ++gm) {
                            f32x16 a;
#pragma unroll
                            for (int r = 0; r < 16; ++r) a[r] = 0.f;
                            const LAS unsigned char* wp = lds + PW_OFF + (gm * 32 + tok) * PW_PITCH + hi * 16;
#pragma unroll
                            for (int ks = 0; ks < 4; ++ks) {
                                const h16x8 wf = *(const LAS h16x8*)(wp + ks * 32);
                                const h16x8 df = (gm < 2) ? dfr[0][ks] : (gm < 4) ? dfr[1][ks] : (gm < 6) ? dfr[2][ks] : dfr[3][ks];
                                a = __builtin_amdgcn_mfma_f32_32x32x16_f16(wf, df, a, 0, 0, 0);
                            }
#pragma unroll
                            for (int r = 0; r < 16; ++r) ss += a[r] * a[r];
                        }
                        ss += __shfl_xor(ss, 32);
                        const float rstd = rsqrtf(ss * (1.f / 256.f) + EPSN);
                        const float* gg = P.g_group + (size_t)l * DM;
#pragma unroll 1
                        for (int gm = 0; gm < 8; ++gm) {
                            f32x16 a;
#pragma unroll
                            for (int r = 0; r < 16; ++r) a[r] = 0.f;
                            const LAS unsigned char* wp = lds + PW_OFF + (gm * 32 + tok) * PW_PITCH + hi * 16;
#pragma unroll
                            for (int ks = 0; ks < 4; ++ks) {
                                const h16x8 wf = *(const LAS h16x8*)(wp + ks * 32);
                                const h16x8 df = (gm < 2) ? dfr[0][ks] : (gm < 4) ? dfr[1][ks] : (gm < 6) ? dfr[2][ks] : dfr[3][ks];
                                a = __builtin_amdgcn_mfma_f32_32x32x16_f16(wf, df, a, 0, 0, 0);
                            }
#pragma unroll
                            for (int r4 = 0; r4 < 4; ++r4) {
                                const f32x4 gv = *(const f32x4*)(gg + gm * 32 + 8 * r4 + 4 * hi);
#pragma unroll
                                for (int e = 0; e < 4; ++e) a[4 * r4 + e] *= rstd * gv[e];
                            }
                            store_tile32(a, stg, HY + (size_t)row0 * DM + gm * 32, DM, lane);
                        }
                    }
                    REPW(14) {
                        const int row0 = opaque_i(it * 32), row = row0 + tok; const h16* zr = Zb + (size_t)row * ZW;
                        h16x8 cf[16]; float ss = 0.f;
#pragma unroll
                        for (int ks = 0; ks < 16; ++ks) { cf[ks] = *(const h16x8*)(zr + ZC_CQ + ks * 16 + hi * 8);
#pragma unroll
                            for (int e = 0; e < 8; ++e) ss += (float)cf[ks][e] * (float)cf[ks][e]; }
                        ss += __shfl_xor(ss, 32);
                        const float sc = rsqrtf(ss * (1.f / 256.f) + EPSN) * (0.10206207261596577f * LOG2E);
                        { const int c0 = tid, c1 = tid + 512; *(LAS u32x4*)(lds + (c0 >> 5) * 528 + (c0 & 31) * 16) = w0; *(LAS u32x4*)(lds + (c1 >> 5) * 528 + (c1 & 31) * 16) = w1; }
                        __syncthreads();
#pragma unroll 1
                        for (int nb = 0; nb < 12; ++nb) {
                            const int bo = (nb & 1) * WB_BYTES;
                            {
                                const int nn = imin(nb + 1, 11); const int c0 = tid, c1 = tid + 512;
                                w0 = *(const u32x4*)(WUQ + (size_t)(nn * 32 + (c0 >> 5)) * 256 + (c0 & 31) * 8); w1 = *(const u32x4*)(WUQ + (size_t)(nn * 32 + (c1 >> 5)) * 256 + (c1 & 31) * 8);
                            }
                            f32x16 a;
#pragma unroll
                            for (int r = 0; r < 16; ++r) a[r] = 0.f;
                            const LAS unsigned char* wp = lds + bo + tok * 528 + hi * 16;
#pragma unroll
                            for (int ks = 0; ks < 16; ++ks) a = __builtin_amdgcn_mfma_f32_32x32x16_f16(*(const LAS h16x8*)(wp + ks * 32), cf[ks], a, 0, 0, 0);
#pragma unroll
                            for (int r = 0; r < 16; ++r) a[r] *= sc;
                            if (nb % 3 == 2) {
#pragma unroll
                                for (int r = 0; r < 8; ++r) {
                                    const int i = (r & 3) + 8 * (r >> 2) + 4 * hi;
                                    const f32x2 cs = *(const f32x2*)(ROPE + ((size_t)t * 16 + i) * 2);
                                    const float x1 = a[r], x2 = a[r + 8];
                                    a[r] = x1 * cs[0] - x2 * cs[1]; a[r + 8] = x1 * cs[1] + x2 * cs[0];
                                }
                            }
                            store_tile32(a, stg, MQ + (size_t)row0 * MQW + nb * 32, MQW, lane);
                            { const int bn = WB_BYTES - bo; const int c0 = tid, c1 = tid + 512; *(LAS u32x4*)(lds + bn + (c0 >> 5) * 528 + (c0 & 31) * 16) = w0; *(LAS u32x4*)(lds + bn + (c1 >> 5) * 528 + (c1 & 31) * 16) = w1; }
                            __syncthreads();
                        }
                    }
                    REPW(15) {
                        const int row0 = opaque_i(it * 32), row = row0 + tok; const h16* zr = Zb + (size_t)row * ZW;
                        h16x8 cf[8]; float ss = 0.f;
#pragma unroll
                        for (int ks = 0; ks < 8; ++ks) { cf[ks] = *(const h16x8*)(zr + ZC_CKV + ks * 16 + hi * 8);
#pragma unroll
                            for (int e = 0; e < 8; ++e) ss += (float)cf[ks][e] * (float)cf[ks][e]; }
                        ss += __shfl_xor(ss, 32);
                        const float sc = rsqrtf(ss * (1.f / 128.f) + EPSN);
                        u32x4 wk = *(const u32x4*)(WUKV + (size_t)(tid >> 4) * 128 + (tid & 15) * 8);
                        *(LAS u32x4*)(lds + (tid >> 4) * 272 + (tid & 15) * 16) = wk;
                        __syncthreads();
#pragma unroll 1
                        for (int nb = 0; nb < 16; ++nb) {
                            const int bo = (nb & 1) * WB_BYTES;
                            { const int nn = imin(nb + 1, 15); wk = *(const u32x4*)(WUKV + (size_t)(nn * 32 + (tid >> 4)) * 128 + (tid & 15) * 8); }
                            f32x16 a;
#pragma unroll
                            for (int r = 0; r < 16; ++r) a[r] = 0.f;
                            const LAS unsigned char* wp = lds + bo + tok * 272 + hi * 16;
#pragma unroll
                            for (int ks = 0; ks < 8; ++ks) a = __builtin_amdgcn_mfma_f32_32x32x16_f16(*(const LAS h16x8*)(wp + ks * 32), cf[ks], a, 0, 0, 0);
                            const int hh = nb >> 2, sub = nb & 3;
#pragma unroll
                            for (int r = 0; r < 16; ++r) a[r] *= sc;
                            if (sub < 2) store_tile32(a, stg, MK + (size_t)row0 * MKW + hh * 96 + sub * 32, MKW, lane);
                            else store_tile32(a, stg, MV + (size_t)row0 * MVW + hh * 64 + (sub - 2) * 32, MVW, lane);
                            *(LAS u32x4*)(lds + (WB_BYTES - bo) + (tid >> 4) * 272 + (tid & 15) * 16) = wk;
                            __syncthreads();
                        }
                        const h16x8 x1 = *(const h16x8*)(zr + ZC_KR + 8 * hi), x2 = *(const h16x8*)(zr + ZC_KR + 16 + 8 * hi);
                        h16x8 o1, o2;
#pragma unroll
                        for (int e = 0; e < 8; ++e) {
                            const f32x2 cs = *(const f32x2*)(ROPE + ((size_t)t * 16 + 8 * hi + e) * 2);
                            const float a1 = (float)x1[e], a2 = (float)x2[e];
                            o1[e] = (h16)(a1 * cs[0] - a2 * cs[1]); o2[e] = (h16)(a1 * cs[1] + a2 * cs[0]);
                        }
#pragma unroll
                        for (int hh = 0; hh < 4; ++hh) { *(h16x8*)(MK + (size_t)row * MKW + hh * 96 + 64 + 8 * hi) = o1; *(h16x8*)(MK + (size_t)row * MKW + hh * 96 + 80 + 8 * hi) = o2; }
                    }
                }
            }
            __syncthreads();
#endif
#if NAIVE_BAND
            { PHASE_ENV(layer)
            for (int it = bx; it < NB * 64 * 4 * 4; it += G) {
                const int qg = it & 3, h = (it >> 2) & 3, ch = (it >> 4) & 63, b = it >> 10;
                const size_t brow = (size_t)b * SEQ; const int q0 = ch * 64 + qg * 16;
                ModBand mod{P.ca_rel + ((size_t)l * 4 + h) * 320, q0};
                nattn_unit<64, ModBand>(lds, Zb + (brow + q0) * ZW + ZC_CAQ + h * 64, ZW, Zb + brow * ZW + ZC_CAK + h * 64, ZW, Zb + brow * ZW + ZC_CAV + h * 64, ZW,
                                        imax(0, (ch - 8) * 64), (ch + 1) * 64, mod, HY + (brow + q0) * DM + 256 + h * 64, DM);
            }
            __syncthreads();
            }
#else
            REP(4) {
                PHASE_ENV(layer)
                LAS float* tabs = (LAS float*)(lds + FA_TAB_OFF);
                for (int i = tid; i < 4 * 384; i += NTHR) { const int hh = i / 384, j = i % 384, idx = imin(imax(382 - j, 0), 319); tabs[i] = P.ca_rel[((size_t)l * 4 + hh) * 320 + idx] * LOG2E; }
                __syncthreads();
                const int vcu = (G % 8 == 0) ? (bx % 8) * (G / 8) + bx / 8 : bx;
                for (int uu = vcu * 4; uu < NB * 4 * 16; uu += G * 4) {
#pragma unroll 1
                    for (int i4 = 0; i4 < 4; ++i4) {
                        const int u = uu + i4, cb = u & 15, bh = u >> 4, b = bh >> 2, h = bh & 3;
                        const int c = 4 * cb + (wave >> 1), qw = 64 * c + 32 * (wave & 1);
                        const size_t brow = (size_t)b * SEQ;
                        FA_UNIT<64, 1>(lds, Zb + (brow + qw) * ZW + ZC_CAQ + h * 64, ZW, Zb + brow * ZW + ZC_CAK + h * 64, ZW, Zb + brow * ZW + ZC_CAV + h * 64, ZW,
                                       imax(0, 4 * cb - 8), 4 * cb + 4, imax(0, c - 8), c + 1, qw, tabs + h * 384, nullptr, HY + (brow + qw) * DM + 256 + h * 64, DM);
                    }
                }
            }
            __syncthreads();
#endif
            IDX_SCORE_ROUND(0);
        }
        SEAM(pb + 1);

        if (IN(pb + 2)) REP(21) { IDX_SELECT_ROUND(0); }
        SEAM(pb + 2);
        if (IN(pb + 3)) REP(20) { IDX_SCORE_ROUND(1); }
        SEAM(pb + 3);
        if (IN(pb + 4)) REP(21) { IDX_SELECT_ROUND(1); }
        SEAM(pb + 4);

        if (IN(pb + 5)) {
#if NAIVE_MLA
            { PHASE_ENV(layer)
            for (int it = bx; it < NB * 256 * 4; it += G) {
                const int h = it & 3, qg = (it >> 2) & 255, b = it >> 10;
                const size_t brow = (size_t)b * SEQ; const int q0 = qg * 16;
                ModNone mod;
                nattn_unit<96, ModNone>(lds, MQ + (brow + q0) * MQW + h * 96, MQW, MK + brow * MKW + h * 96, MKW, MV + brow * MVW + h * 64, MVW,
                                        0, ((q0 >> 6) + 1) * 64, mod, HY + (brow + q0) * DM + 768 + h * 64, DM);
            }
            }
#else
            REP(6) {
                PHASE_ENV(layer)
                const int vcu = (G % 8 == 0) ? (bx % 8) * (G / 8) + bx / 8 : bx;
                for (int uu = vcu * 4; uu < NB * 4 * 16; uu += G * 4) {
#pragma unroll 1
                    for (int i4 = 0; i4 < 4; ++i4) {
                        const int bh = uu >> 4, s = (uu >> 2) & 3, qb = (i4 == 0) ? s : (i4 == 1) ? 15 - s : (i4 == 2) ? 7 - s : 8 + s;
                        const int b = bh >> 2, h = bh & 3;
                        const size_t brow = (size_t)b * SEQ; const int qw = qb * 256 + wave * 32;
                        FA_UNIT<96, 0>(lds, MQ + (brow + qw) * MQW + h * 96, MQW, MK + brow * MKW + h * 96, MKW, MV + brow * MVW + h * 64, MVW,
                                       0, 4 * qb + 4, 0, (qw >> 6) + 1, qw, nullptr, nullptr, HY + (brow + qw) * DM + 768 + h * 64, DM);
                    }
                }
            }
#endif
#if NAIVE_DSA_ATTN
            { PHASE_ENV(layer)
            for (int it = bx; it < NB * 256 * 4; it += G) {
                const int h = it & 3, qg = (it >> 2) & 255, b = it >> 10;
                const size_t brow = (size_t)b * SEQ; const int q0 = qg * 16;
                ModDsa mod{BM + (brow + q0) * 64, P.t5, h, q0};
                nattn_unit<64, ModDsa>(lds, Zb + (brow + q0) * ZW + ZC_SAQ + h * 64, ZW, Zb + brow * ZW + ZC_SAK, ZW, Zb + brow * ZW + ZC_SAV, ZW,
                                       0, ((q0 >> 6) + 1) * 64, mod, HY + (brow + q0) * DM + 512 + h * 64, DM);
            }
            }
#else
            REP(7) {
                PHASE_ENV(layer)
                __syncthreads();
                LAS float* tabs = (LAS float*)(lds + FA_TAB_OFF);
                for (int i = tid; i < 4 * 384; i += NTHR) { const int hh = i / 384, j = i % 384, idx = imin(imax(382 - j, 0), 319); tabs[i] = P.t5[t5_bucket(63 - idx) * 4 + hh] * LOG2E; }
                __syncthreads();
                const int vcu = (G % 8 == 0) ? (bx % 8) * (G / 8) + bx / 8 : bx;
                for (int uu = vcu; uu < NB * 16; uu += G) {
#pragma unroll 1
                    for (int i4 = 0; i4 < 4; ++i4) {
                        const int b = uu >> 4, s = uu & 15, qc = (i4 == 0) ? s : (i4 == 1) ? 63 - s : (i4 == 2) ? 31 - s : 32 + s;
                        const int h = wave & 3, qw = 64 * qc + 32 * (wave >> 2);
                        const size_t brow = (size_t)b * SEQ;
                        FA_UNIT<64, 2>(lds, Zb + (brow + qw) * ZW + ZC_SAQ + h * 64, ZW, Zb + brow * ZW + ZC_SAK, ZW, Zb + brow * ZW + ZC_SAV, ZW,
                                       0, qc + 1, 0, qc + 1, qw, tabs + h * 384, BM + (brow + qw) * 64, HY + (brow + qw) * DM + 512 + h * 64, DM);
                    }
                }
            }
#endif
        }
        SEAM(pb + 5);

        if (IN(pb + 6)) { PHASE_ENV(layer)
            for (int row = gw; row < MROWS; row += ngw) {
#pragma unroll
                for (int g = 1; g < 4; ++g) {
                    h16* yp = HY + (size_t)row * DM + g * 256 + 4 * lane;
                    const h16x4 u = *(const h16x4*)yp;
                    const float a0 = (float)u[0], a1 = (float)u[1], a2 = (float)u[2], a3 = (float)u[3];
                    const float rstd = rsqrtf(wave_sum((a0 * a0 + a1 * a1) + (a2 * a2 + a3 * a3)) * (1.f / 256.f) + EPSN);
                    const f32x4 gg = *(const f32x4*)(P.g_group + (size_t)l * DM + g * 256 + 4 * lane);
                    h16x4 o; o[0] = (h16)(a0 * rstd * gg.x); o[1] = (h16)(a1 * rstd * gg.y); o[2] = (h16)(a2 * rstd * gg.z); o[3] = (h16)(a3 * rstd * gg.w);
                    *(h16x4*)yp = o;
                }
            }
        }
        SEAM(pb + 6);

        if (IN(pb + 7)) { PHASE_ENV(layer)
            h16* X16 = (h16*)(ws + WS_X16);
            pg8::Gemm g_{HY, (const h16*)(wl + WO_OUT), MROWS, DM, DM}; pg8::StaticOrder S_; S_.init(MROWS, DM, G, bx);
            if (l == 0) {
                EpiResN<true> E{P.x, nullptr, X16, modl + 2 * 1024, (h16*)(ws + WS_XG), (const float*)(ws + WS_GMOD) + ((size_t)l * 2 + 1) * 16 * 1024, (float*)(ws + WS_SSQ) + (size_t)(2 * l + 1) * MROWS};
                pg8::gemm_phase<EpiResN<true>, pg8::StaticOrder, true, true>(lds, g_, S_, E);
            } else {
                EpiResN<false> E{nullptr, X16, X16, modl + 2 * 1024, (h16*)(ws + WS_XG), (const float*)(ws + WS_GMOD) + ((size_t)l * 2 + 1) * 16 * 1024, (float*)(ws + WS_SSQ) + (size_t)(2 * l + 1) * MROWS};
                pg8::gemm_phase<EpiResN<false>, pg8::StaticOrder, true, true>(lds, g_, S_, E);
            }
        }
        SEAM(pb + 7);

        if (IN(pb + 8)) REP(8) { PHASE_ENV(layer) EpiSwin E{HID, (const float*)(ws + WS_SSQ) + (size_t)(2 * l + 1) * MROWS, (const float*)(ws + WS_SHW) + (size_t)l * 16 * 8192 + 2560};
            pg8::Gemm g_{(const h16*)(ws + WS_XG), (const h16*)(wl + WO_UP), MROWS, FF2, DM}; pg8::StaticOrder S_; S_.init(MROWS, FF2, G, bx);
            pg8::gemm_phase<EpiSwin, pg8::StaticOrder, true, true>(lds, g_, S_, E); }
        SEAM(pb + 8);

        if (IN(pb + 9)) { PHASE_ENV(layer)
            const bool nxt = (l + 1 < NLAYER);
            h16* X16 = (h16*)(ws + WS_X16);
            EpiResN<false> E{nullptr, X16, X16, modl + 5 * 1024, nxt ? (h16*)(ws + WS_XG) : (h16*)nullptr, (const float*)(ws + WS_GMOD) + ((size_t)(nxt ? l + 1 : l) * 2 + 0) * 16 * 1024, (float*)(ws + WS_SSQ) + (size_t)(2 * (nxt ? l + 1 : l)) * MROWS};
            pg8::Gemm g_{HID, (const h16*)(wl + WO_DN), MROWS, DM, FF}; pg8::StaticOrder S_; S_.init(MROWS, DM, G, bx);
            pg8::gemm_phase<EpiResN<false>, pg8::StaticOrder, true, true>(lds, g_, S_, E);
        }
        SEAM(pb + 9);
    }

    if (IN(NPHASE - 1)) { PHASE_ENV(0)
        const h16* X16 = (const h16*)(ws + WS_X16);
        for (int rp = gw; rp < MROWS / 2; rp += ngw) {
            const int row0 = 2 * rp;
            h16x8 xh[2][2]; float s[2] = {0.f, 0.f};
#pragma unroll
            for (int r = 0; r < 2; ++r)
#pragma unroll
                for (int j = 0; j < 2; ++j) xh[r][j] = *(const h16x8*)(X16 + (size_t)(row0 + r) * DM + 8 * lane + 512 * j);
#pragma unroll
            for (int r = 0; r < 2; ++r)
#pragma unroll
                for (int j = 0; j < 2; ++j)
#pragma unroll
                    for (int e = 0; e < 8; ++e) { const float f = (float)xh[r][j][e]; s[r] += f * f; }
            const float r0 = rsqrtf(wave_sum(s[0]) * (1.f / DM) + EPSN), r1 = rsqrtf(wave_sum(s[1]) * (1.f / DM) + EPSN);
#pragma unroll
            for (int j = 0; j < 2; ++j) {
                const int c0 = 8 * lane + 512 * j;
                const f32x4 g0 = *(const f32x4*)(P.g_final + c0), g1 = *(const f32x4*)(P.g_final + c0 + 4);
                f32x4 a0, a1, b0, b1;
#pragma unroll
                for (int e = 0; e < 4; ++e) { a0[e] = (float)xh[0][j][e] * r0 * g0[e]; a1[e] = (float)xh[0][j][4 + e] * r0 * g1[e]; b0[e] = (float)xh[1][j][e] * r1 * g0[e]; b1[e] = (float)xh[1][j][4 + e] * r1 * g1[e]; }
                *(f32x4*)(P.out + (size_t)row0 * DM + c0) = a0; *(f32x4*)(P.out + (size_t)row0 * DM + c0 + 4) = a1;
                *(f32x4*)(P.out + (size_t)(row0 + 1) * DM + c0) = b0; *(f32x4*)(P.out + (size_t)(row0 + 1) * DM + c0 + 4) = b1;
            }
        }
    }
#undef IN
#undef SEAM
}

extern "C" void kernel_launch(void* const* d_in, const int* in_sizes, int n_in, void* d_out, int out_size, void* d_ws, size_t ws_size, hipStream_t stream) {
    static int grid = 0;
    if (grid == 0) {
        if (n_in != 21 || out_size != MROWS * DM || ws_size < WS_END) { fprintf(stderr, "kernel_launch: unexpected problem (n_in %d out %d ws %zu)\n", n_in, out_size, ws_size); grid = -1; return; }
        int dev = 0, cus = 0, per_cu = 0;
        if (hipGetDevice(&dev) != hipSuccess || hipDeviceGetAttribute(&cus, hipDeviceAttributeMultiprocessorCount, dev) != hipSuccess) { grid = -1; return; }
        if (hipFuncSetAttribute((const void*)fwd, hipFuncAttributeMaxDynamicSharedMemorySize, LDS_BYTES) != hipSuccess) { fprintf(stderr, "kernel_launch: hipFuncSetAttribute failed\n"); grid = -1; return; }
        if (hipOccupancyMaxActiveBlocksPerMultiprocessor(&per_cu, (const void*)fwd, NTHR, LDS_BYTES) != hipSuccess || per_cu < 1) fprintf(stderr, "kernel_launch: occupancy query says %d\n", per_cu);
        (void)hipGetLastError();
        grid = cus;
    }
    if (grid < 0) return;
    (void)hipMemsetAsync((char*)d_ws + WS_CTL, 0, CTL_ZERO_BYTES, stream);
    (void)hipMemsetAsync((char*)d_ws + WS_SSQ, 0, 1 * MiB, stream);
    Args a{};
    Ptrs& p = a.p;
    p.x = (const float*)d_in[0]; p.c = (const float*)d_in[1]; p.t5 = (const float*)d_in[2]; p.w_mod = (const float*)d_in[3]; p.b_mod = (const float*)d_in[4];
    p.g_mix = (const float*)d_in[5]; p.w_in = (const float*)d_in[6]; p.pool_w = (const float*)d_in[7]; p.pool_scale = (const float*)d_in[8]; p.ca_rel = (const float*)d_in[9];
    p.g_cq = (const float*)d_in[10]; p.g_ckv = (const float*)d_in[11]; p.w_uq = (const float*)d_in[12]; p.w_ukv = (const float*)d_in[13]; p.g_group = (const float*)d_in[14];
    p.w_out = (const float*)d_in[15]; p.g_ffn = (const float*)d_in[16]; p.w1 = (const float*)d_in[17]; p.w3 = (const float*)d_in[18]; p.w2 = (const float*)d_in[19]; p.g_final = (const float*)d_in[20];
    p.out = (float*)d_out; p.ws = (unsigned char*)d_ws;
#if MK_ONE_LAUNCH
    a.ph_lo = 0; a.ph_hi = NPHASE; a.use_bar = 1;
    hipLaunchKernelGGL(fwd, dim3(grid), dim3(NTHR), LDS_BYTES, stream, a);
#else
    for (int ph = 0; ph < NPHASE; ++ph) {
        a.ph_lo = ph; a.ph_hi = ph + 1; a.use_bar = 0;
        hipLaunchKernelGGL(fwd, dim3(grid), dim3(NTHR), LDS_BYTES, stream, a);
    }
#endif
    const hipError_t le = hipPeekAtLastError();
    if (le != hipSuccess) fprintf(stderr, "kernel_launch: launch failed: %s\n", hipGetErrorName(le));
}
```
